# Optimizing an MI355X kernel written in HIP

```python
import jax, jax.numpy as jnp
from jax import lax
import numpy as np

D_MODEL = 2048
BATCH = 1
SEQ = 16384
DEPTH = 2
DEC_BATCH = 32
DEC_SEQ = 16
PAST_LEN = 2048

CHUNK = 64
N_A_LAYERS = DEPTH // 2
N_B_LAYERS = DEPTH - N_A_LAYERS
D_RNN = D_MODEL
N_LRU_HEADS = 16
LRU_BLOCK = D_RNN // N_LRU_HEADS
CONV_W = 4
LRU_C = 8.0
N_HEADS = 16
HEAD_DIM = D_MODEL // N_HEADS
D_FF = 4 * D_MODEL
Q_BLOCK = 128
EPS = 1e-6

kernel_name = 'yoco_rglru_stickbreaking_stream_step'


def rmsnorm(x, g):
    xf = x.astype(jnp.float32)
    y = xf * lax.rsqrt(jnp.mean(xf * xf, axis=-1, keepdims=True) + EPS)
    return (y * g.astype(jnp.float32)).astype(x.dtype)


def _lin_combine(left, right):
    a1, b1 = left
    a2, b2 = right
    return a1 * a2, a2 * b1 + b2


def conv_rglru(xn, conv_buf, h0, pos0, w_in, conv_w, conv_b, w_r, b_r, w_i, b_i, lam, w_out):
    bn, s, _ = xn.shape
    u = xn @ w_in
    gate = jax.nn.gelu(u[..., :D_RNN])
    rec = u[..., D_RNN:]
    padded = jnp.concatenate([conv_buf.astype(rec.dtype), rec], axis=1)
    new_buf = padded[:, -(CONV_W - 1):]
    c = conv_b + padded[:, 0:s] * conv_w[0]
    for j in range(1, CONV_W):
        c = c + padded[:, j:j + s] * conv_w[j]
    cb = c.reshape(bn, s, N_LRU_HEADS, LRU_BLOCK)
    r = jax.nn.sigmoid((jnp.einsum('bshi,hij->bshj', cb, w_r).reshape(bn, s, D_RNN) + b_r).astype(jnp.float32))
    i = jax.nn.sigmoid((jnp.einsum('bshi,hij->bshj', cb, w_i).reshape(bn, s, D_RNN) + b_i).astype(jnp.float32))
    log_a = -LRU_C * r * jax.nn.softplus(-lam.astype(jnp.float32))
    a = jnp.exp(log_a)
    pos = pos0 + jnp.arange(s)
    mult = jnp.where((pos == 0)[None, :, None], 1.0, jnp.sqrt(-jnp.expm1(2.0 * log_a)))
    b = mult * i * c.astype(jnp.float32)
    b = b.at[:, 0].add(a[:, 0] * h0.astype(jnp.float32))
    _, h = lax.associative_scan(_lin_combine, (a, b), axis=1)
    y = (h.astype(xn.dtype) * gate) @ w_out
    return y, h[:, -1], new_buf


def stick_breaking(q, k, v, q_pos0):
    nq = q.shape[1]
    nk = k.shape[1]
    z = jnp.einsum('bqhd,bkhd->bhqk', q, k).astype(jnp.float32) * (HEAD_DIM ** -0.5)
    valid = jnp.arange(nk)[None, :] < (q_pos0 + jnp.arange(nq))[:, None]
    log_keep = jnp.where(valid, jax.nn.log_sigmoid(-z), 0.0)
    suffix = lax.cumsum(log_keep, axis=3, reverse=True)
    suffix_excl = jnp.concatenate([suffix[..., 1:], jnp.zeros_like(suffix[..., :1])], axis=-1)
    w = jnp.where(valid, jnp.exp(jax.nn.log_sigmoid(z) + suffix_excl), 0.0)
    return jnp.einsum('bhqk,bkhd->bqhd', w.astype(v.dtype), v)


def sq_relu_mlp(x, g, w_up, w_down):
    h = jax.nn.relu(rmsnorm(x, g) @ w_up)
    return (h * h) @ w_down


def trunk(x, conv_bufs, h0s, pos0, past_k, past_v, p):
    bn, s, _ = x.shape
    new_h, new_buf = [], []
    k_new = v_new = k_all = v_all = None
    for layer in range(DEPTH):
        if layer < N_A_LAYERS:
            l = layer
            y, h_last, buf = conv_rglru(rmsnorm(x, p['a_norm'][l]), conv_bufs[l], h0s[l], pos0,
                                        p['a_w_in'][l], p['a_conv_w'][l], p['a_conv_b'][l],
                                        p['a_w_r'][l], p['a_b_r'][l], p['a_w_i'][l], p['a_b_i'][l],
                                        p['a_lambda'][l], p['a_w_out'][l])
            x = x + y
            new_h.append(h_last.astype(x.dtype))
            new_buf.append(buf)
        else:
            if layer == N_A_LAYERS:
                kv = (rmsnorm(x, p['kv_norm']) @ p['w_kv']).reshape(bn, s, 2, N_HEADS, HEAD_DIM)
                k_new = rmsnorm(kv[:, :, 0], p['k_norm'])
                v_new = kv[:, :, 1]
                if past_k is None:
                    k_all, v_all = k_new, v_new
                else:
                    k_all = jnp.concatenate([past_k.astype(k_new.dtype), k_new], axis=1)
                    v_all = jnp.concatenate([past_v.astype(v_new.dtype), v_new], axis=1)
            l = layer - N_A_LAYERS
            q = (rmsnorm(x, p['b_norm'][l]) @ p['b_w_q'][l]).reshape(bn, s, N_HEADS, HEAD_DIM)
            q = rmsnorm(q, p['b_q_norm'][l])
            if past_k is None:
                nb = s // Q_BLOCK
                qb = q.reshape(bn, nb, Q_BLOCK, N_HEADS, HEAD_DIM).swapaxes(0, 1)
                ob = lax.map(lambda args: stick_breaking(args[0], k_all, v_all, args[1]),
                             (qb, jnp.arange(nb) * Q_BLOCK))
                o = ob.swapaxes(0, 1).reshape(bn, s, N_HEADS * HEAD_DIM)
            else:
                o = stick_breaking(q, k_all, v_all, pos0).reshape(bn, s, N_HEADS * HEAD_DIM)
            x = x + o @ p['b_w_o'][l]
        x = x + sq_relu_mlp(x, p['mlp_norm'][layer], p['mlp_w_up'][layer], p['mlp_w_down'][layer])
    return x, jnp.stack(new_h), jnp.stack(new_buf), k_new, v_new


def setup_inputs(seed: int = 0) -> dict:
    key = jax.random.key(seed)
    ks = jax.random.split(key, 32)
    f32 = jnp.float32

    def nrm(k, shape, scale):
        return jax.random.normal(k, shape, f32) * scale

    def gain(k, shape):
        return 1.0 + 0.01 * jax.random.normal(k, shape, f32)

    a_c = jax.random.uniform(ks[10], (N_A_LAYERS, D_RNN), f32, 0.81, 0.998)
    base = a_c ** (1.0 / LRU_C)
    a_lambda = jnp.log(base) - jnp.log1p(-base)
    return {
        'x_prompt': nrm(ks[0], (BATCH, SEQ, D_MODEL), 1.0),
        'x_sample': nrm(ks[1], (DEC_BATCH, DEC_SEQ, D_MODEL), 1.0),
        'state_lru_h': nrm(ks[2], (N_A_LAYERS, DEC_BATCH, D_RNN), 0.5),
        'state_conv': nrm(ks[3], (N_A_LAYERS, DEC_BATCH, CONV_W - 1, D_RNN), 1.0),
        'cache_k': nrm(ks[4], (DEC_BATCH, PAST_LEN, N_HEADS, HEAD_DIM), 1.0),
        'cache_v': nrm(ks[5], (DEC_BATCH, PAST_LEN, N_HEADS, HEAD_DIM), 1.0),
        'a_norm': gain(ks[6], (N_A_LAYERS, D_MODEL)),
        'a_w_in': nrm(ks[7], (N_A_LAYERS, D_MODEL, 2 * D_RNN), D_MODEL ** -0.5),
        'a_conv_w': nrm(ks[8], (N_A_LAYERS, CONV_W, D_RNN), CONV_W ** -0.5),
        'a_conv_b': nrm(ks[9], (N_A_LAYERS, D_RNN), 0.01),
        'a_w_r': nrm(ks[11], (N_A_LAYERS, N_LRU_HEADS, LRU_BLOCK, LRU_BLOCK), LRU_BLOCK ** -0.5),
        'a_b_r': nrm(ks[12], (N_A_LAYERS, D_RNN), 0.01),
        'a_w_i': nrm(ks[13], (N_A_LAYERS, N_LRU_HEADS, LRU_BLOCK, LRU_BLOCK), LRU_BLOCK ** -0.5),
        'a_b_i': nrm(ks[14], (N_A_LAYERS, D_RNN), 0.01),
        'a_lambda': a_lambda,
        'a_w_out': nrm(ks[15], (N_A_LAYERS, D_RNN, D_MODEL), D_RNN ** -0.5),
        'kv_norm': gain(ks[16], (D_MODEL,)),
        'w_kv': nrm(ks[17], (D_MODEL, 2 * N_HEADS * HEAD_DIM), D_MODEL ** -0.5),
        'k_norm': gain(ks[18], (HEAD_DIM,)),
        'b_norm': gain(ks[19], (N_B_LAYERS, D_MODEL)),
        'b_w_q': nrm(ks[20], (N_B_LAYERS, D_MODEL, N_HEADS * HEAD_DIM), D_MODEL ** -0.5),
        'b_q_norm': gain(ks[21], (N_B_LAYERS, HEAD_DIM)),
        'b_w_o': nrm(ks[22], (N_B_LAYERS, N_HEADS * HEAD_DIM, D_MODEL), (N_HEADS * HEAD_DIM) ** -0.5),
        'mlp_norm': gain(ks[23], (DEPTH, D_MODEL)),
        'mlp_w_up': nrm(ks[24], (DEPTH, D_MODEL, D_FF), D_MODEL ** -0.5),
        'mlp_w_down': nrm(ks[25], (DEPTH, D_FF, D_MODEL), D_FF ** -0.5),
    }


def reference(x_prompt, x_sample, state_lru_h, state_conv, cache_k, cache_v,
              a_norm, a_w_in, a_conv_w, a_conv_b, a_w_r, a_b_r, a_w_i, a_b_i, a_lambda, a_w_out,
              kv_norm, w_kv, k_norm, b_norm, b_w_q, b_q_norm, b_w_o,
              mlp_norm, mlp_w_up, mlp_w_down):
    p = {'a_norm': a_norm, 'a_w_in': a_w_in, 'a_conv_w': a_conv_w, 'a_conv_b': a_conv_b,
         'a_w_r': a_w_r, 'a_b_r': a_b_r, 'a_w_i': a_w_i, 'a_b_i': a_b_i, 'a_lambda': a_lambda,
         'a_w_out': a_w_out, 'kv_norm': kv_norm, 'w_kv': w_kv, 'k_norm': k_norm,
         'b_norm': b_norm, 'b_w_q': b_w_q, 'b_q_norm': b_q_norm, 'b_w_o': b_w_o,
         'mlp_norm': mlp_norm, 'mlp_w_up': mlp_w_up, 'mlp_w_down': mlp_w_down}
    bp = x_prompt.shape[0]
    zero_conv = jnp.zeros((N_A_LAYERS, bp, CONV_W - 1, D_RNN), x_prompt.dtype)
    zero_h = jnp.zeros((N_A_LAYERS, bp, D_RNN), x_prompt.dtype)
    y_prompt, p_lru_h, p_conv, p_k, p_v = trunk(x_prompt, zero_conv, zero_h, 0, None, None, p)
    y_sample, s_lru_h, s_conv, s_k, s_v = trunk(x_sample, state_conv, state_lru_h, PAST_LEN,
                                                 cache_k, cache_v, p)
    return (y_prompt, y_sample, p_lru_h, p_conv, p_k, p_v, s_lru_h, s_conv, s_k, s_v)
```

```cpp
#include <hip/hip_runtime.h>
#include <cstdio>
#include <cstdint>
namespace pg8 {
#define PG8_LAS __attribute__((address_space(3)))
typedef unsigned short bf16_t;
typedef short bf16x8 __attribute__((ext_vector_type(8)));
typedef float f32x4 __attribute__((ext_vector_type(4)));
typedef unsigned u32x4 __attribute__((ext_vector_type(4)));
constexpr int BM = 256, BK = 64, HALF = 128, HTB = HALF * BK * 2  , STAGE_BYTES = 8 * HTB, NXCD = 8, WGM = 8;

__host__ __device__ __forceinline__ int lds_byte(int r, int c) { const int st = (r >> 4) * 2 + (c >> 5), rr = r & 15, cc = c & 31, ob = rr * 64 + cc * 2; return st * 1024 + (ob ^ (((ob >> 9) & 1) << 5)); }
__host__ __device__ __forceinline__ void stage_rc(int b, int& R, int& C) { const int st = b / 1024, sb = b % 1024, swz = sb ^ (((sb >> 9) & 1) << 5); R = (st >> 1) * 16 + swz / 64; C = (st & 1) * 32 + (swz % 64) / 2; }
__host__ __device__ __forceinline__ int perm32(int rho) { const int n = rho >> 4, i = rho & 15; return 8 * (i >> 2) + 4 * n + (i & 3); }

struct Unit { int pm, pn; };
struct Gemm { const bf16_t* A; const bf16_t* Bt; int M, N, K; };

struct StaticOrder {
    int nM, nN, nwg, G, c;
    __host__ __device__ void init(int M, int N, int G_, int c_) { nM = M / BM; nN = N / BM; nwg = nM * nN; G = G_; c = c_; }
    __host__ __device__ bool next(int i, Unit& u) const {
        const long L = (long)i * G + c; if (L >= nwg) return false;
        int wgid = (int)L; { const int q = nwg / NXCD, r = nwg % NXCD, xcd = wgid % NXCD, off = wgid / NXCD; wgid = (xcd < r ? xcd * (q + 1) : r * (q + 1) + (xcd - r) * q) + off; }
        const int nig = WGM * nN, gid = wgid / nig, fm = gid * WGM, gsz = (nM - fm) < WGM ? (nM - fm) : WGM;
        u.pm = fm + ((wgid % nig) % gsz); u.pn = (wgid % nig) / gsz; return true;
    }
    __device__ __forceinline__ void a_ready(const Unit&) const {}
    __device__ __forceinline__ void done(const Unit&) const {}
};

__device__ __forceinline__ unsigned cvt_pk_bf16(float lo, float hi) { unsigned r; asm volatile("v_cvt_pk_bf16_f32 %0, %1, %2" : "=v"(r) : "v"(lo), "v"(hi)); return r; }
__device__ __forceinline__ u32x4 pack8(const f32x4 v0, const f32x4 v1) { u32x4 w; w.x = cvt_pk_bf16(v0[0], v0[1]); w.y = cvt_pk_bf16(v0[2], v0[3]); w.z = cvt_pk_bf16(v1[0], v1[1]); w.w = cvt_pk_bf16(v1[2], v1[3]); return w; }
constexpr int MPROMPT = 16384, DM = 2048;
constexpr float RMS_EPS = 1e-6f;
__device__ __forceinline__ float rstd_of(float ss, float inv_n) { return __builtin_amdgcn_rsqf(ss * inv_n + RMS_EPS); }
__device__ __forceinline__ float gelu_tanh(float x) { const float t = x * (1.0f + 0.044715f * x * x) * (-2.302208198f); return x * __builtin_amdgcn_rcpf(1.0f + __builtin_amdgcn_exp2f(t)); }

struct EpiIn {
    static constexpr bool PERM = true, AFTER_DRAIN = false;
    bf16_t* gate; bf16_t* rec; const float* ss; float* pconv; float* sconv;
    __device__ __forceinline__ void operator()(const f32x4 (&acc)[2][2][4][2], const Unit& u, int wr, int wc, int fr, int fq) const {
        const int row0 = u.pm * BM + wr * 64 + fr; const bool is_gate = u.pn < 8; const int col0 = (u.pn & 7) * BM + wc * 32 + 8 * fq;
        bf16_t* base = is_gate ? gate : rec;
#pragma unroll
        for (int ai = 0; ai < 2; ++ai)
#pragma unroll
            for (int m = 0; m < 4; ++m) { const int row = row0 + ai * HALF + m * 16; const float rs = rstd_of(ss[row], 1.0f / 2048.0f);
                float* cdst = nullptr;
                if (!is_gate) { if (row >= MPROMPT - 3 && row < MPROMPT) cdst = pconv + (size_t)(row - (MPROMPT - 3)) * DM;
                                else if (row >= MPROMPT && ((row - MPROMPT) & 15) >= 13) cdst = sconv + ((size_t)((row - MPROMPT) >> 4) * 3 + (((row - MPROMPT) & 15) - 13)) * DM; }
#pragma unroll
                for (int bj = 0; bj < 2; ++bj) { f32x4 v0 = acc[ai][bj][m][0] * rs, v1 = acc[ai][bj][m][1] * rs;
                    if (cdst) { *(f32x4*)(cdst + col0 + bj * HALF) = v0; *(f32x4*)(cdst + col0 + bj * HALF + 4) = v1; }
                    if (is_gate) { v0 = (f32x4){gelu_tanh(v0[0]), gelu_tanh(v0[1]), gelu_tanh(v0[2]), gelu_tanh(v0[3])}; v1 = (f32x4){gelu_tanh(v1[0]), gelu_tanh(v1[1]), gelu_tanh(v1[2]), gelu_tanh(v1[3])}; }
                    *(u32x4*)(base + (size_t)row * DM + col0 + bj * HALF) = pack8(v0, v1); } }
    }
};
template <bool FINAL> struct EpiResid {
    static constexpr bool PERM = true, AFTER_DRAIN = false;
    const float* resP; const float* resS; float* X; bf16_t* XB; float* SS;
    __device__ __forceinline__ void operator()(const f32x4 (&acc)[2][2][4][2], const Unit& u, int wr, int wc, int fr, int fq) const {
        const int row0 = u.pm * BM + wr * 64 + fr, col0 = u.pn * BM + wc * 32 + 8 * fq;
        const float* rb = (u.pm < MPROMPT / BM) ? resP : resS - (size_t)MPROMPT * DM;
#pragma unroll
        for (int ai = 0; ai < 2; ++ai)
#pragma unroll
            for (int m = 0; m < 4; ++m) { const int row = row0 + ai * HALF + m * 16; const size_t off = (size_t)row * DM + col0; float q = 0.f;
#pragma unroll
                for (int bj = 0; bj < 2; ++bj) { const f32x4 r0 = *(const f32x4*)(rb + off + bj * HALF), r1 = *(const f32x4*)(rb + off + bj * HALF + 4);
                    const f32x4 x0 = r0 + acc[ai][bj][m][0], x1 = r1 + acc[ai][bj][m][1];
                    *(f32x4*)(X + off + bj * HALF) = x0; *(f32x4*)(X + off + bj * HALF + 4) = x1;
                    if (!FINAL) { *(u32x4*)(XB + off + bj * HALF) = pack8(x0, x1);
                        q += (x0[0] * x0[0] + x0[1] * x0[1]) + (x0[2] * x0[2] + x0[3] * x0[3]) + (x1[0] * x1[0] + x1[1] * x1[1]) + (x1[2] * x1[2] + x1[3] * x1[3]); } }
                if (!FINAL) { q += __shfl_xor(q, 16); q += __shfl_xor(q, 32); if (fq == 0) atomicAdd(SS + row, q); } }
    }
};
struct EpiUp {
    static constexpr bool PERM = true, AFTER_DRAIN = false;
    bf16_t* H; int ldc; const float* ss;
    __device__ __forceinline__ void operator()(const f32x4 (&acc)[2][2][4][2], const Unit& u, int wr, int wc, int fr, int fq) const {
        const int row0 = u.pm * BM + wr * 64 + fr, col0 = u.pn * BM + wc * 32 + 8 * fq;
#pragma unroll
        for (int ai = 0; ai < 2; ++ai)
#pragma unroll
            for (int m = 0; m < 4; ++m) { const int row = row0 + ai * HALF + m * 16; const float rs = rstd_of(ss[row], 1.0f / 2048.0f);
#pragma unroll
                for (int bj = 0; bj < 2; ++bj) { f32x4 v0 = acc[ai][bj][m][0] * rs, v1 = acc[ai][bj][m][1] * rs;
#pragma unroll
                    for (int e = 0; e < 4; ++e) { const float a = fmaxf(v0[e], 0.f), b = fmaxf(v1[e], 0.f); v0[e] = a * a; v1[e] = b * b; }
                    *(u32x4*)(H + (size_t)row * ldc + col0 + bj * HALF) = pack8(v0, v1); } }
    }
};
struct EpiKVQ {
    static constexpr bool PERM = true, AFTER_DRAIN = false;
    float* kP; float* kS; float* vP; float* vS; bf16_t* Q; const float* ss; const float* gk; const float* gq; float qscale; PG8_LAS float* ex;
    __device__ __forceinline__ void operator()(const f32x4 (&acc)[2][2][4][2], const Unit& u, int wr, int wc, int fr, int fq) const {
        const int row0 = u.pm * BM + wr * 64 + fr; const int kind = u.pn >> 3; const int col0 = (u.pn & 7) * BM + wc * 32 + 8 * fq;
        const bool prompt = u.pm < MPROMPT / BM;
        float rs[2][4];
#pragma unroll
        for (int ai = 0; ai < 2; ++ai)
#pragma unroll
            for (int m = 0; m < 4; ++m) rs[ai][m] = rstd_of(ss[row0 + ai * HALF + m * 16], 1.0f / 2048.0f);
        if (kind == 1) {
            float* vb = prompt ? vP : vS - (size_t)MPROMPT * DM;
#pragma unroll
            for (int ai = 0; ai < 2; ++ai)
#pragma unroll
                for (int m = 0; m < 4; ++m) { const size_t off = (size_t)(row0 + ai * HALF + m * 16) * DM + col0;
#pragma unroll
                    for (int bj = 0; bj < 2; ++bj) { *(f32x4*)(vb + off + bj * HALF) = acc[ai][bj][m][0] * rs[ai][m]; *(f32x4*)(vb + off + bj * HALF + 4) = acc[ai][bj][m][1] * rs[ai][m]; } }
            return;
        }
#pragma unroll
        for (int ai = 0; ai < 2; ++ai)
#pragma unroll
            for (int m = 0; m < 4; ++m)
#pragma unroll
                for (int bj = 0; bj < 2; ++bj) { const f32x4 v0 = acc[ai][bj][m][0] * rs[ai][m], v1 = acc[ai][bj][m][1] * rs[ai][m];
                    float q = (v0[0] * v0[0] + v0[1] * v0[1]) + (v0[2] * v0[2] + v0[3] * v0[3]) + (v1[0] * v1[0] + v1[1] * v1[1]) + (v1[2] * v1[2] + v1[3] * v1[3]);
                    q += __shfl_xor(q, 16); q += __shfl_xor(q, 32);
                    if (fq == 0) ex[((ai * HALF + wr * 64 + m * 16 + fr) * 2 + bj) * 4 + wc] = q; }
        asm volatile("s_waitcnt lgkmcnt(0)" ::: "memory"); __builtin_amdgcn_s_barrier(); asm volatile("" ::: "memory");
        const float* g = (kind == 0) ? gk : gq; const int gc0 = wc * 32 + 8 * fq;
        const f32x4 g0 = *(const f32x4*)(g + gc0), g1 = *(const f32x4*)(g + gc0 + 4);
        float* kb = prompt ? kP : kS - (size_t)MPROMPT * DM;
#pragma unroll
        for (int ai = 0; ai < 2; ++ai)
#pragma unroll
            for (int m = 0; m < 4; ++m) { const size_t off = (size_t)(row0 + ai * HALF + m * 16) * DM + col0;
#pragma unroll
                for (int bj = 0; bj < 2; ++bj) { const f32x4 e = *(const PG8_LAS f32x4*)(ex + ((ai * HALF + wr * 64 + m * 16 + fr) * 2 + bj) * 4);
                    const float hs = rstd_of((e[0] + e[1]) + (e[2] + e[3]), 1.0f / 128.0f) * rs[ai][m];
                    f32x4 v0 = acc[ai][bj][m][0] * hs * g0, v1 = acc[ai][bj][m][1] * hs * g1;
                    if (kind == 0) { *(f32x4*)(kb + off + bj * HALF) = v0; *(f32x4*)(kb + off + bj * HALF + 4) = v1; }
                    else { v0 = v0 * qscale; v1 = v1 * qscale; *(u32x4*)(Q + off + bj * HALF) = pack8(v0, v1); } } }
        asm volatile("s_waitcnt lgkmcnt(0)" ::: "memory"); __builtin_amdgcn_s_barrier(); asm volatile("" ::: "memory");
    }
};

template <class Epi, class Sched, bool ALIGN_EPI = false, bool SP2 = false>
__device__ __forceinline__ void gemm_phase(PG8_LAS unsigned char* lds, const Gemm g, const Sched& S, const Epi& E) {
    const int tid = threadIdx.x, wid = __builtin_amdgcn_readfirstlane(tid >> 6), lane = tid & 63, wr = wid >> 2, wc = wid & 3, fr = lane & 15, fq = lane >> 4;
    const int K = g.K, nt = K / BK;
    unsigned voffA[2], voffB[2];
#pragma unroll
    for (int i = 0; i < 2; ++i) { int R, C; stage_rc(tid * 16 + i * 8192, R, C); const int Rb = Epi::PERM ? ((R & ~31) + perm32(R & 31)) : R;
        voffA[i] = (unsigned)(R * K + C) * 2u; voffB[i] = (unsigned)(Rb * K + C) * 2u; }
    const size_t kstep = (size_t)(BK * 2);
    const size_t hstep = (size_t)HALF * K * 2;
    const size_t tstep = 2 * hstep;
    const unsigned ldsw = (unsigned)wid * 1024u;
    const int aoff = lds_byte(wr * 64 + fr, fq * 8), boff = lds_byte(wc * 32 + fr, fq * 8);
#define PG8_SA(b, h) (((b) * 2 + (h)) * HTB)
#define PG8_SB(b, h) ((4 + (b) * 2 + (h)) * HTB)
#define PG8_STAGE(bufoff, gbase, voff) do { _Pragma("unroll") for (int _i = 0; _i < 2; ++_i) \
        __builtin_amdgcn_global_load_lds((const unsigned*)((const char*)(gbase) + (voff)[_i]), (PG8_LAS unsigned*)(lds + (bufoff) + ldsw + _i * 8192), 16, 0, 0); } while (0)
#define PG8_LDA(dst, b, h) do { _Pragma("unroll") for (int m = 0; m < 4; ++m) _Pragma("unroll") for (int k = 0; k < 2; ++k) dst[m][k] = *(const PG8_LAS bf16x8*)(lds + PG8_SA(b, h) + aoff + m * 2048 + k * 1024); } while (0)
#define PG8_LDB(dst, b, h) do { _Pragma("unroll") for (int n = 0; n < 2; ++n) _Pragma("unroll") for (int k = 0; k < 2; ++k) dst[n][k] = *(const PG8_LAS bf16x8*)(lds + PG8_SB(b, h) + boff + n * 2048 + k * 1024); } while (0)
#define PG8_MMA(ai, bj, At, Bt) do { __builtin_amdgcn_s_setprio(1); _Pragma("unroll") for (int m = 0; m < 4; ++m) _Pragma("unroll") for (int n = 0; n < 2; ++n) _Pragma("unroll") for (int k = 0; k < 2; ++k) \
        acc[ai][bj][m][n] = __builtin_amdgcn_mfma_f32_16x16x32_bf16(Bt[n][k], At[m][k], acc[ai][bj][m][n], 0, 0, 0); __builtin_amdgcn_s_setprio(0); } while (0)
#define PG8_WAIT_V(n) asm volatile("s_waitcnt vmcnt(" #n ")" ::: "memory")
#define PG8_WAIT_L(n) asm volatile("s_waitcnt lgkmcnt(" #n ")" ::: "memory")
#define PG8_BAR __builtin_amdgcn_s_barrier()
#define PG8_SCHED __builtin_amdgcn_sched_barrier(0)
    Unit cur, nxt; int ui = 0;
    if (!S.next(0, cur)) return;
    f32x4 acc[2][2][4][2];
#pragma unroll
    for (int a = 0; a < 2; ++a)
#pragma unroll
        for (int b = 0; b < 2; ++b)
#pragma unroll
            for (int m = 0; m < 4; ++m)
#pragma unroll
                for (int n = 0; n < 2; ++n) acc[a][b][m][n] = (f32x4){0.f, 0.f, 0.f, 0.f};
    bf16x8 At[4][2], B0[2][2], B1[2][2];
    const char* cA = (const char*)g.A + (size_t)cur.pm * tstep; const char* cB = (const char*)g.Bt + (size_t)cur.pn * tstep;
    S.a_ready(cur);
    if constexpr (SP2) {
        PG8_STAGE(PG8_SB(0, 0), cB, voffB); PG8_STAGE(PG8_SB(0, 1), cB + hstep, voffB); PG8_STAGE(PG8_SA(0, 0), cA, voffA); PG8_STAGE(PG8_SA(0, 1), cA + hstep, voffA);
        if (wr == 1) PG8_BAR;
        PG8_WAIT_V(2); PG8_BAR;
        PG8_STAGE(PG8_SB(1, 0), cB + kstep, voffB); PG8_STAGE(PG8_SA(1, 0), cA + kstep, voffA); PG8_STAGE(PG8_SB(1, 1), cB + hstep + kstep, voffB);
        PG8_WAIT_V(6); PG8_BAR;
    } else {
        PG8_STAGE(PG8_SB(0, 0), cB, voffB); PG8_STAGE(PG8_SA(0, 0), cA, voffA); PG8_STAGE(PG8_SB(0, 1), cB + hstep, voffB); PG8_STAGE(PG8_SA(0, 1), cA + hstep, voffA);
        if (wr == 1) PG8_BAR;
        PG8_WAIT_V(4); PG8_BAR;
        PG8_STAGE(PG8_SB(1, 0), cB + kstep, voffB); PG8_STAGE(PG8_SA(1, 0), cA + kstep, voffA); PG8_STAGE(PG8_SB(1, 1), cB + hstep + kstep, voffB);
        PG8_WAIT_V(6); PG8_BAR;
    }
    for (;;) {
        const bool has_next = S.next(ui + 1, nxt);
        const char* nA = has_next ? (const char*)g.A + (size_t)nxt.pm * tstep : cA; const char* nB = has_next ? (const char*)g.Bt + (size_t)nxt.pn * tstep : cB;
        for (int t = 0; t < nt; t += 2) {
            const bool last = (t == nt - 2);
            const char* a1 = cA + (size_t)(t + 1) * kstep;
            const char* a2 = last ? nA : cA + (size_t)(t + 2) * kstep; const char* b2 = last ? nB : cB + (size_t)(t + 2) * kstep;
            const char* a3 = a2 + kstep; const char* b3 = b2 + kstep;
            if (last && has_next) S.a_ready(nxt);
            if constexpr (SP2) {
            PG8_LDB(B0, 0, 0); PG8_LDB(B1, 0, 1); PG8_SCHED; PG8_LDA(At, 0, 0); PG8_STAGE(PG8_SA(1, 1), a1 + hstep, voffA);
            PG8_WAIT_V(8); PG8_WAIT_L(0); PG8_BAR; PG8_MMA(0, 0, At, B0); PG8_MMA(0, 1, At, B1); PG8_BAR; PG8_SCHED;
            PG8_LDA(At, 0, 1); PG8_STAGE(PG8_SB(0, 0), b2, voffB); PG8_STAGE(PG8_SB(0, 1), b2 + hstep, voffB); PG8_STAGE(PG8_SA(0, 0), a2, voffA);
            PG8_WAIT_V(8); PG8_WAIT_L(0); PG8_BAR; PG8_MMA(1, 0, At, B0); PG8_MMA(1, 1, At, B1); PG8_BAR; PG8_SCHED;
            PG8_LDB(B0, 1, 0); PG8_LDB(B1, 1, 1); PG8_SCHED; PG8_LDA(At, 1, 0); PG8_STAGE(PG8_SA(0, 1), a2 + hstep, voffA);
            PG8_WAIT_V(8); PG8_WAIT_L(0); PG8_BAR; PG8_MMA(0, 0, At, B0); PG8_MMA(0, 1, At, B1); PG8_BAR; PG8_SCHED;
            PG8_LDA(At, 1, 1); PG8_STAGE(PG8_SB(1, 0), b3, voffB); PG8_STAGE(PG8_SB(1, 1), b3 + hstep, voffB); PG8_STAGE(PG8_SA(1, 0), a3, voffA);
            PG8_WAIT_V(8); PG8_WAIT_L(0); PG8_BAR; PG8_MMA(1, 0, At, B0); PG8_MMA(1, 1, At, B1); PG8_BAR; PG8_SCHED;
            } else {
            PG8_LDB(B0, 0, 0); PG8_SCHED; PG8_LDA(At, 0, 0); PG8_STAGE(PG8_SA(1, 1), a1 + hstep, voffA);
            PG8_WAIT_L(8); PG8_BAR; PG8_WAIT_L(0); PG8_MMA(0, 0, At, B0); PG8_BAR; PG8_SCHED;
            PG8_LDB(B1, 0, 1); PG8_STAGE(PG8_SB(0, 0), b2, voffB);
            PG8_BAR; PG8_WAIT_L(0); PG8_MMA(0, 1, At, B1); PG8_BAR;
            PG8_LDA(At, 0, 1); PG8_STAGE(PG8_SA(0, 0), a2, voffA);
            PG8_BAR; PG8_WAIT_L(0); PG8_MMA(1, 0, At, B0); PG8_BAR; PG8_SCHED;
            PG8_STAGE(PG8_SB(0, 1), b2 + hstep, voffB);
            PG8_WAIT_V(6); PG8_BAR; PG8_MMA(1, 1, At, B1); PG8_BAR;
            PG8_LDB(B0, 1, 0); PG8_SCHED; PG8_LDA(At, 1, 0); PG8_STAGE(PG8_SA(0, 1), a2 + hstep, voffA);
            PG8_WAIT_L(8); PG8_BAR; PG8_WAIT_L(0); PG8_MMA(0, 0, At, B0); PG8_BAR; PG8_SCHED;
            PG8_LDB(B1, 1, 1); PG8_STAGE(PG8_SB(1, 0), b3, voffB);
            PG8_BAR; PG8_WAIT_L(0); PG8_MMA(0, 1, At, B1); PG8_BAR;
            PG8_LDA(At, 1, 1); PG8_STAGE(PG8_SA(1, 0), a3, voffA);
            PG8_BAR; PG8_WAIT_L(0); PG8_MMA(1, 0, At, B0); PG8_BAR; PG8_SCHED;
            PG8_STAGE(PG8_SB(1, 1), b3 + hstep, voffB);
            PG8_WAIT_V(6); PG8_BAR; PG8_MMA(1, 1, At, B1); PG8_BAR;
            }
        }
        if constexpr (ALIGN_EPI) { if (wr == 0) PG8_BAR; }
        if constexpr (!Epi::AFTER_DRAIN) { E(acc, cur, wr, wc, fr, fq); S.done(cur); }
        if (!has_next) break;
#pragma unroll
        for (int a = 0; a < 2; ++a)
#pragma unroll
            for (int b = 0; b < 2; ++b)
#pragma unroll
                for (int m = 0; m < 4; ++m)
#pragma unroll
                    for (int n = 0; n < 2; ++n) acc[a][b][m][n] = (f32x4){0.f, 0.f, 0.f, 0.f};
        cur = nxt; cA = nA; cB = nB; ++ui;
        if constexpr (ALIGN_EPI) { if (wr == 1) PG8_BAR; }
    }
    PG8_WAIT_V(0);
    if constexpr (!ALIGN_EPI) { if (wr == 0) PG8_BAR; }
    PG8_BAR;
    if constexpr (Epi::AFTER_DRAIN) { E.fused(acc, cur, wr, wc, fr, fq, lds, wid, lane); S.done(cur); }
#undef PG8_SA
#undef PG8_SB
#undef PG8_STAGE
#undef PG8_LDA
#undef PG8_LDB
#undef PG8_MMA
#undef PG8_WAIT_V
#undef PG8_WAIT_L
#undef PG8_BAR
#undef PG8_SCHED
}
}

#ifndef MK_N_LAUNCHES
#define MK_N_LAUNCHES 12
#endif
constexpr int NWAVES = 8;
constexpr int N_PHASES = 12;
constexpr int D = 2048, MP = 16384, MS = 512, M = MP + MS, NH = 16, HD = 128, FF = 8192, PAST = 2048, DECB = 32, DECS = 16, NQKV = 3 * D;
constexpr int LRU_TC = 128, LRU_NCP = MP / LRU_TC  , LRU_NCS = MS / LRU_TC  ;
constexpr size_t O_Y = 0, O_PLRU = (size_t)M * D, O_PCONV = O_PLRU + D, O_PK = O_PCONV + 3 * D, O_PV = O_PK + (size_t)MP * D, O_SLRU = O_PV + (size_t)MP * D,
                 O_SCONV = O_SLRU + (size_t)DECB * D, O_SK = O_SCONV + (size_t)DECB * 3 * D, O_SV = O_SK + (size_t)MS * D, O_END = O_SV + (size_t)MS * D;
static_assert(O_END == 104079360, "d_out map");
constexpr size_t MiB = 1u << 20;
constexpr size_t WS_CTL = 0, CTL_ZERO_BYTES = 1 * MiB;
constexpr size_t WS_WIN = 2 * MiB, WS_WOUT = WS_WIN + 16 * MiB, WS_WUP0 = WS_WOUT + 8 * MiB, WS_WDN0 = WS_WUP0 + 32 * MiB, WS_WKVQ = WS_WDN0 + 32 * MiB, WS_WO = WS_WKVQ + 24 * MiB,
                 WS_WUP1 = WS_WO + 8 * MiB, WS_WDN1 = WS_WUP1 + 32 * MiB, WS_WR = WS_WDN1 + 32 * MiB, WS_WI = WS_WR + 1 * MiB, WS_AGGA = WS_WI + 1 * MiB, WS_AGGB = WS_AGGA + 1 * MiB,
                 WS_SS0 = WS_AGGB + 1 * MiB, WS_XB = WS_SS0 + 1 * MiB, WS_GATE = WS_XB + 66 * MiB, WS_REC = WS_GATE + 66 * MiB, WS_HG = WS_REC + 66 * MiB, WS_QB = WS_HG + 66 * MiB,
                 WS_OB = WS_QB + 66 * MiB, WS_H = WS_OB + 66 * MiB, WS_END = WS_H + 264 * MiB;
static_assert((size_t)M * D * 2 == 66 * MiB && (size_t)M * FF * 2 == 264 * MiB, "activation sizes");
constexpr int CW_BAR = 4096;
constexpr int CW_SS1 = 32768, CW_SS2 = CW_SS1 + 32768, CW_SS3 = CW_SS2 + 32768;
static_assert(M <= 32768 && (CW_SS3 + 32768) * 4 <= (int)CTL_ZERO_BYTES, "CTL words inside the memset region");
constexpr int RING_OFF = 0, RING_BYTES = 131072;
constexpr int EX_OFF = RING_BYTES, EX_BYTES = 8192;
constexpr int LDSCTL_OFF = EX_OFF + EX_BYTES, MISC_OFF = LDSCTL_OFF + 320;
constexpr int LDS_BYTES = 147456;
static_assert(MISC_OFF + 128 <= LDS_BYTES, "LDS map");

#define GAS __attribute__((address_space(1)))
#define LAS __attribute__((address_space(3)))
typedef unsigned short bf16;
typedef unsigned v4u __attribute__((ext_vector_type(4)));
typedef unsigned v2u __attribute__((ext_vector_type(2)));
typedef float f32x4 __attribute__((ext_vector_type(4)));
typedef float f32x16 __attribute__((ext_vector_type(16)));
typedef short bf16x8 __attribute__((ext_vector_type(8)));
typedef GAS unsigned gu32;
#define RLX_AGENT __ATOMIC_RELAXED, __HIP_MEMORY_SCOPE_AGENT
#define LDS_WAIT() asm volatile("s_waitcnt lgkmcnt(0)" ::: "memory")
#define VM_WAIT() asm volatile("s_waitcnt vmcnt(0)" ::: "memory")
__device__ __forceinline__ unsigned f2bf(float f) { unsigned u = __builtin_bit_cast(unsigned, f); return (u + 0x7fffu + ((u >> 16) & 1u)) >> 16; }
__device__ __forceinline__ unsigned pk2(float lo, float hi) { return f2bf(lo) | (f2bf(hi) << 16); }
__device__ __forceinline__ float bf2f(unsigned short b) { return __builtin_bit_cast(float, (unsigned)b << 16); }
__device__ __forceinline__ float sigmoidf_(float x) { return __builtin_amdgcn_rcpf(1.0f + __builtin_amdgcn_exp2f(-1.4426950408889634f * x)); }
#define XB_TMO      128
#define XB_XCNT(j)  (256  + 64 * (j))
#define XB_XSUB(j)  (1280 + 64 * (j))
#define XB_XGEN(j)  (2304 + 64 * (j))
#define XB_TOP      3328
#define XB_TOPGEN   3392
#define XCD_BAR_WORDS 3456
#define XB_SPIN_CAP (1u << 21)

__device__ __forceinline__ unsigned xb_ld(unsigned* p)              { return __hip_atomic_load(p, __ATOMIC_RELAXED, __HIP_MEMORY_SCOPE_AGENT); }
__device__ __forceinline__ unsigned xb_add(unsigned* p, unsigned v) { return __hip_atomic_fetch_add(p, v, __ATOMIC_RELAXED, __HIP_MEMORY_SCOPE_AGENT); }
__device__ __forceinline__ unsigned xb_xcc_id() { return (unsigned)__builtin_amdgcn_s_getreg((3 << 11) | 20) & 0xFu; }
#define XB_SPIN(cond, bar) do { unsigned _sp = 0; while (cond) { __builtin_amdgcn_s_sleep(1); \
    if ((++_sp & 255u) == 0u) { if (xb_ld(&(bar)[XB_TMO])) break; if (_sp > XB_SPIN_CAP) { atomicAdd(&(bar)[XB_TMO], 1u); break; } } } } while (0)

struct XcdBarrier {
    unsigned* bar; unsigned x;
    volatile LAS unsigned* st;
};

__device__ __forceinline__ XcdBarrier xcd_barrier_post(unsigned* bar, volatile LAS unsigned* st) {
    XcdBarrier b; b.bar = bar; b.x = xb_xcc_id(); b.st = st;
    if (threadIdx.x == 0) (void)xb_add(&bar[XB_XCNT(b.x)], 1u);
    return b;
}
__device__ __forceinline__ void xcd_barrier_complete(unsigned* bar, unsigned x, unsigned& nloc, unsigned& nx) {
    const unsigned G = gridDim.x * gridDim.y * gridDim.z;
    unsigned sum, cnt, mine, sp = 0u;
    for (;;) {
        sum = 0u; cnt = 0u; mine = 0u;
#pragma unroll
        for (unsigned j = 0; j < 16; ++j) { const unsigned c = xb_ld(&bar[XB_XCNT(j)]); sum += c; cnt += (c > 0u) ? 1u : 0u; mine = (j == x) ? c : mine; }
        if (sum == G) break;
        __builtin_amdgcn_s_sleep(1);
        if ((++sp & 255u) == 0u) { if (xb_ld(&bar[XB_TMO])) break; if (sp > XB_SPIN_CAP) { atomicAdd(&bar[XB_TMO], 1u); break; } }
    }
    nloc = mine > 0u ? mine : 1u; nx = cnt > 0u ? cnt : 1u;
}

__device__ __forceinline__ void xcd_barrier(const XcdBarrier& b) {
    asm volatile("s_waitcnt vmcnt(0)" ::: "memory");
    __syncthreads();
    if (threadIdx.x == 0) {
        unsigned* bar = b.bar;
        __builtin_amdgcn_s_waitcnt(0);
        unsigned nloc = b.st[0], nx = b.st[1];
        if (nloc == 0u) { xcd_barrier_complete(bar, b.x, nloc, nx); b.st[0] = nloc; b.st[1] = nx; }
        const unsigned old = xb_add(&bar[XB_XSUB(b.x)], 1u);
        const unsigned gen = old / nloc;
        if (old + 1u == (gen + 1u) * nloc) {
            __builtin_amdgcn_fence(__ATOMIC_RELEASE, "agent");
            asm volatile("s_waitcnt vmcnt(0)" ::: "memory");
            const unsigned og = xb_add(&bar[XB_TOP], 1u);
            const unsigned tg = og / nx;
            if (og + 1u == (tg + 1u) * nx) xb_add(&bar[XB_TOPGEN], 1u);
            else XB_SPIN(xb_ld(&bar[XB_TOPGEN]) == tg, bar);
            __builtin_amdgcn_fence(__ATOMIC_ACQUIRE, "agent");
            xb_add(&bar[XB_XGEN(b.x)], 1u);
            asm volatile("s_waitcnt vmcnt(0)" ::: "memory");
        } else {
            XB_SPIN(xb_ld(&bar[XB_XGEN(b.x)]) == gen, bar);
            __builtin_amdgcn_fence(__ATOMIC_ACQUIRE, "agent");
            asm volatile("s_waitcnt vmcnt(0)" ::: "memory");
        }
    }
    __syncthreads();
}

struct Frame {
    LAS unsigned char* lds;
    volatile LAS unsigned* MISC;
    gu32* ctl;
    int tid, lane, wave;
    int vcu, G;
    const float* const* in;
    unsigned char* ws; float* out;
};

__device__ __forceinline__ float wave_sum(float v) {
#pragma unroll
    for (int o = 1; o < 64; o <<= 1) v += __shfl_xor(v, o);
    return v;
}
__device__ __forceinline__ void p0_transpose_item(const float* W, int K, int N, bf16* WT, int row_off, const float* gain, LAS float* scr, int item, int lane) {
    const int nblk = N / 32, kb = item / nblk, nb = item % nblk, k0 = 64 * kb, n0 = 32 * nb;
#pragma unroll 8
    for (int i = 0; i < 32; ++i) { const int kk = 2 * i + (lane >> 5); const float gk = gain ? gain[k0 + kk] : 1.0f; scr[kk * 33 + (lane & 31)] = W[(size_t)(k0 + kk) * N + n0 + (lane & 31)] * gk; }
    LDS_WAIT(); asm volatile("" ::: "memory");
    const int c = lane & 7;
#pragma unroll
    for (int j = 0; j < 4; ++j) { const int n = (lane >> 3) + 8 * j; const LAS float* s = scr + (8 * c) * 33 + n;
        v4u o; o.x = pk2(s[0 * 33], s[1 * 33]); o.y = pk2(s[2 * 33], s[3 * 33]); o.z = pk2(s[4 * 33], s[5 * 33]); o.w = pk2(s[6 * 33], s[7 * 33]);
        *(GAS v4u*)(WT + (size_t)(row_off + n0 + n) * K + k0 + 8 * c) = o; }
    LDS_WAIT(); asm volatile("" ::: "memory");
}
__device__ __forceinline__ void x_row_to_bf16(const float* xrow, bf16* orow, float* ssp, int lane) {
    const GAS f32x4* xr = (const GAS f32x4*)xrow + lane;
    f32x4 v[8]; float s = 0.f;
#pragma unroll
    for (int j = 0; j < 8; ++j) { v[j] = xr[64 * j]; s += (v[j].x * v[j].x + v[j].y * v[j].y) + (v[j].z * v[j].z + v[j].w * v[j].w); }
    s = wave_sum(s);
    GAS unsigned long long* o8 = (GAS unsigned long long*)orow + lane;
#pragma unroll
    for (int j = 0; j < 8; ++j) o8[64 * j] = (unsigned long long)pk2(v[j].x, v[j].y) | ((unsigned long long)pk2(v[j].z, v[j].w) << 32);
    if (lane == 0) *ssp = s;
}
struct P0Args { const float* const* in; unsigned char* ws; };
__device__ __forceinline__ void p0_prologue(Frame& F, const float* const* in) {
    LAS float* scr = (LAS float*)(F.lds + RING_OFF + F.wave * 16384);
    const int gw = F.vcu * NWAVES + F.wave, NGW = F.G * NWAVES;
    unsigned char* ws = F.ws;
    constexpr int I_IN = (D / 64) * (2 * D / 32), I_SQ = (D / 64) * (D / 32), I_UP = (D / 64) * (FF / 32), I_DN = (FF / 64) * (D / 32), I_G = 16 * (HD / 64) * (HD / 32);
    constexpr int NITEMS = I_IN + I_SQ + I_UP + I_DN + I_IN + I_SQ + I_SQ + I_UP + I_DN + I_G + I_G;
    for (int it = gw; it < NITEMS; it += NGW) {
        int r = it;
        if (r < I_IN) { p0_transpose_item(in[7], D, 2 * D, (bf16*)(ws + WS_WIN), 0, in[6], scr, r, F.lane); continue; } r -= I_IN;
        if (r < I_SQ) { p0_transpose_item(in[15], D, D, (bf16*)(ws + WS_WOUT), 0, nullptr, scr, r, F.lane); continue; } r -= I_SQ;
        if (r < I_UP) { p0_transpose_item(in[24], D, FF, (bf16*)(ws + WS_WUP0), 0, in[23], scr, r, F.lane); continue; } r -= I_UP;
        if (r < I_DN) { p0_transpose_item(in[25], FF, D, (bf16*)(ws + WS_WDN0), 0, nullptr, scr, r, F.lane); continue; } r -= I_DN;
        if (r < I_IN) { p0_transpose_item(in[17], D, 2 * D, (bf16*)(ws + WS_WKVQ), 0, in[16], scr, r, F.lane); continue; } r -= I_IN;
        if (r < I_SQ) { p0_transpose_item(in[20], D, D, (bf16*)(ws + WS_WKVQ), 2 * D, in[19], scr, r, F.lane); continue; } r -= I_SQ;
        if (r < I_SQ) { p0_transpose_item(in[22], D, D, (bf16*)(ws + WS_WO), 0, nullptr, scr, r, F.lane); continue; } r -= I_SQ;
        if (r < I_UP) { p0_transpose_item(in[24] + (size_t)D * FF, D, FF, (bf16*)(ws + WS_WUP1), 0, in[23] + D, scr, r, F.lane); continue; } r -= I_UP;
        if (r < I_DN) { p0_transpose_item(in[25] + (size_t)D * FF, FF, D, (bf16*)(ws + WS_WDN1), 0, nullptr, scr, r, F.lane); continue; } r -= I_DN;
        if (r < I_G) { const int h = r / 8; p0_transpose_item(in[10] + (size_t)h * HD * HD, HD, HD, (bf16*)(ws + WS_WR) + (size_t)h * HD * HD, 0, nullptr, scr, r % 8, F.lane); continue; } r -= I_G;
        { const int h = r / 8; p0_transpose_item(in[12] + (size_t)h * HD * HD, HD, HD, (bf16*)(ws + WS_WI) + (size_t)h * HD * HD, 0, nullptr, scr, r % 8, F.lane); }
    }
    bf16* XB = (bf16*)(ws + WS_XB); float* SS0 = (float*)(ws + WS_SS0);
    for (int m = gw; m < M; m += NGW) x_row_to_bf16(m < MP ? in[0] + (size_t)m * D : in[1] + (size_t)(m - MP) * D, XB + (size_t)m * D, SS0 + m, F.lane);
}

constexpr int CB_STRIDE = 272;
constexpr int LRU_CB_OFF = 0, LRU_GT_OFF = 128 * CB_STRIDE;
template <int PASS> __device__ __forceinline__ void lru_phase(Frame& F, const float* const* in) {
    typedef float f32x4v __attribute__((ext_vector_type(4)));
    const int tid = F.tid, lane = F.lane, w = F.wave, fr = lane & 15, fq = lane >> 4;
    const int nslot = F.G / 16, h = blockIdx.x % 16, slot = blockIdx.x / 16;
    if (slot >= nslot) return;
    unsigned char* ws = F.ws;
    const bf16* REC = (const bf16*)(ws + WS_REC); const bf16* GATE = (const bf16*)(ws + WS_GATE); bf16* HG = (bf16*)(ws + WS_HG);
    float* AGGA = (float*)(ws + WS_AGGA); float* AGGB = (float*)(ws + WS_AGGB);
    LAS unsigned char* Cb = F.lds + RING_OFF + LRU_CB_OFF; LAS unsigned char* Gt = F.lds + RING_OFF + LRU_GT_OFF;
    const int ch = h * HD + 16 * w + fr;
    const float br = in[11][ch], bi = in[13][ch];
    float sp2;
    { const float lam = in[14][ch]; const float sp = fmaxf(-lam, 0.f) + log1pf(expf(-fabsf(lam))); sp2 = 8.0f * sp * 1.4426950408889634f; }
    bf16x8 wrf[4], wif[4];
    { const bf16* wr_t = (const bf16*)(ws + WS_WR) + ((size_t)(h * HD + 16 * w + fr) * HD + 8 * fq); const bf16* wi_t = (const bf16*)(ws + WS_WI) + ((size_t)(h * HD + 16 * w + fr) * HD + 8 * fq);
#pragma unroll
      for (int ks = 0; ks < 4; ++ks) { wrf[ks] = *(const bf16x8*)(wr_t + 32 * ks); wif[ks] = *(const bf16x8*)(wi_t + 32 * ks); } }
    const int ch4 = (tid & 31) * 4, rg = tid >> 5;
    f32x4v cw[4], cbv;
#pragma unroll
    for (int k = 0; k < 4; ++k) cw[k] = *(const f32x4v*)(in[8] + (size_t)k * D + h * HD + ch4);
    cbv = *(const f32x4v*)(in[9] + h * HD + ch4);
    const int nchunk = (PASS == 1) ? LRU_NCP : (LRU_NCP + LRU_NCS);
    for (int c = slot; c < nchunk; c += nslot) {
        const bool sample = c >= LRU_NCP;
        const int row0 = sample ? MP + (c - LRU_NCP) * LRU_TC : c * LRU_TC;
        __syncthreads();
        {
            float xr[11][4];
#pragma unroll
            for (int k = 0; k < 11; ++k) {
                const int lr = rg * 8 - 3 + k;
                bool zero = false; const float* st = nullptr;
                if (k < 3) { if (sample) { if ((rg & 1) == 0) st = in[3] + ((size_t)((row0 - MP + rg * 8) >> 4) * 3 + k) * D + h * HD + ch4; }
                             else if (c == 0 && rg == 0) zero = true; }
                if (zero) { xr[k][0] = xr[k][1] = xr[k][2] = xr[k][3] = 0.f; }
                else if (st) { const f32x4v s4 = *(const f32x4v*)st; xr[k][0] = s4[0]; xr[k][1] = s4[1]; xr[k][2] = s4[2]; xr[k][3] = s4[3]; }
                else { const v2u p = *(const v2u*)(REC + (size_t)(row0 + lr) * D + h * HD + ch4);
                       xr[k][0] = __builtin_bit_cast(float, p.x << 16); xr[k][1] = __builtin_bit_cast(float, p.x & 0xffff0000u); xr[k][2] = __builtin_bit_cast(float, p.y << 16); xr[k][3] = __builtin_bit_cast(float, p.y & 0xffff0000u); }
            }
#pragma unroll
            for (int r = 0; r < 8; ++r) { float o[4];
#pragma unroll
                for (int e = 0; e < 4; ++e) o[e] = cbv[e] + cw[0][e] * xr[r][e] + cw[1][e] * xr[r + 1][e] + cw[2][e] * xr[r + 2][e] + cw[3][e] * xr[r + 3][e];
                v2u pk; pk.x = pk2(o[0], o[1]); pk.y = pk2(o[2], o[3]);
                *(LAS v2u*)(Cb + (rg * 8 + r) * CB_STRIDE + ch4 * 2) = pk; }
            if (PASS == 2) {
#pragma unroll
                for (int i = 0; i < 4; ++i) { const int id = tid + 512 * i, rr = id >> 4, cc = id & 15;
                    *(LAS v4u*)(Gt + rr * CB_STRIDE + cc * 16) = *(const v4u*)(GATE + (size_t)(row0 + rr) * D + h * HD + cc * 8); }
            }
        }
        __syncthreads();
        float Hin = 0.f;
        if (PASS == 2 && !sample) {
            const int lo = (c * fq) >> 2, hi = (c * (fq + 1)) >> 2;
            float Ap = 1.f, Bp = 0.f;
            for (int cc = lo; cc < hi; ++cc) { const float a = AGGA[(size_t)cc * D + ch], b = AGGB[(size_t)cc * D + ch]; Bp = a * Bp + b; Ap = a * Ap; }
            { const float Aq = __shfl_up(Ap, 16), Bq = __shfl_up(Bp, 16); if (fq >= 1) { Bp = Ap * Bq + Bp; Ap = Ap * Aq; } }
            { const float Aq = __shfl_up(Ap, 32), Bq = __shfl_up(Bp, 32); if (fq >= 2) { Bp = Ap * Bq + Bp; Ap = Ap * Aq; } }
            Hin = __shfl(Bp, 48 + fr);
        }
        float Atot = 1.f, Btot = 0.f;
#pragma unroll 1
        for (int mt = 0; mt < LRU_TC / 16; ++mt) {
            const int t0 = mt * 16;
            f32x4v racc = {0.f, 0.f, 0.f, 0.f}, iacc = {0.f, 0.f, 0.f, 0.f};
#pragma unroll
            for (int ks = 0; ks < 4; ++ks) { const bf16x8 af = *(const LAS bf16x8*)(Cb + (t0 + fr) * CB_STRIDE + (32 * ks + 8 * fq) * 2);
                racc = __builtin_amdgcn_mfma_f32_16x16x32_bf16(af, wrf[ks], racc, 0, 0, 0); iacc = __builtin_amdgcn_mfma_f32_16x16x32_bf16(af, wif[ks], iacc, 0, 0, 0); }
            if (PASS == 2 && sample) Hin = in[2][(size_t)((row0 - MP + t0) >> 4) * D + ch];
            float pa[4], pb[4]; float Ar = 1.f, Br = 0.f;
#pragma unroll
            for (int r = 0; r < 4; ++r) { const int t = t0 + 4 * fq + r;
                const float cv = bf2f(*(const LAS unsigned short*)(Cb + t * CB_STRIDE + (16 * w + fr) * 2));
                const float rr = sigmoidf_(racc[r] + br), ii = sigmoidf_(iacc[r] + bi);
                const float a = __builtin_amdgcn_exp2f(-rr * sp2);
                float mult = __builtin_sqrtf(fmaxf(1.0f - a * a, 0.f));
                if (!sample && row0 + t == 0) mult = 1.0f;
                const float b = mult * ii * cv;
                Br = a * Br + b; Ar = a * Ar; pa[r] = Ar; pb[r] = Br; }
            float Ai = Ar, Bi = Br;
            { const float Aq = __shfl_up(Ai, 16), Bq = __shfl_up(Bi, 16); if (fq >= 1) { Bi = Ai * Bq + Bi; Ai = Ai * Aq; } }
            { const float Aq = __shfl_up(Ai, 32), Bq = __shfl_up(Bi, 32); if (fq >= 2) { Bi = Ai * Bq + Bi; Ai = Ai * Aq; } }
            if (PASS == 1) {
                const float At = __shfl(Ai, 48 + fr), Bt = __shfl(Bi, 48 + fr);
                Btot = At * Btot + Bt; Atot = At * Atot;
            } else {
                float Ae = __shfl_up(Ai, 16), Be = __shfl_up(Bi, 16); if (fq == 0) { Ae = 1.f; Be = 0.f; }
                const float hin = Ae * Hin + Be;
                float hv[4];
#pragma unroll
                for (int r = 0; r < 4; ++r) hv[r] = pa[r] * hin + pb[r];
#pragma unroll
                for (int r = 0; r < 4; ++r) { const int t = t0 + 4 * fq + r; LAS unsigned short* gp = (LAS unsigned short*)(Gt + t * CB_STRIDE + (16 * w + fr) * 2);
                    const float g = bf2f(*gp); *gp = (unsigned short)f2bf(hv[r] * g); }
                if (fq == 3) {
                    if (sample) F.out[O_SLRU + (size_t)((row0 - MP + t0) >> 4) * D + ch] = hv[3];
                    else if (c == LRU_NCP - 1 && mt == LRU_TC / 16 - 1) F.out[O_PLRU + ch] = hv[3];
                }
                Hin = __shfl(hv[3], 48 + fr);
            }
        }
        if (PASS == 1) { if (fq == 0) { AGGA[(size_t)c * D + ch] = Atot; AGGB[(size_t)c * D + ch] = Btot; } }
        else {
            __syncthreads();
#pragma unroll
            for (int i = 0; i < 4; ++i) { const int id = tid + 512 * i, rr = id >> 4, cc = id & 15;
                *(v4u*)(HG + (size_t)(row0 + rr) * D + h * HD + cc * 8) = *(const LAS v4u*)(Gt + rr * CB_STRIDE + cc * 16); }
        }
    }
}

constexpr int AT_STRIDE = 272, AT_K_OFF = 0, AT_V_OFF = 64 * AT_STRIDE, AT_FLAG_OFF = 2 * 64 * AT_STRIDE;
constexpr float ATT_STOP = -160.0f;
constexpr int AT_NUP = (MP / 256) * NH, AT_NUS = DECB * NH, AT_NU = AT_NUP + AT_NUS;
__device__ __forceinline__ int crow16(int r, int hi) { return (r & 3) + 8 * (r >> 2) + 4 * hi; }
__device__ __forceinline__ void attn_phase(Frame& F, const float* const* in) {
    const int tid = F.tid, lane = F.lane, w = F.wave, ql = lane & 31, hi = lane >> 5;
    unsigned char* ws = F.ws;
    const bf16* QB = (const bf16*)(ws + WS_QB); bf16* OB = (bf16*)(ws + WS_OB);
    const float* pk = F.out + O_PK; const float* pv = F.out + O_PV; const float* sk = F.out + O_SK; const float* sv = F.out + O_SV; const float* ck = in[4]; const float* cv = in[5];
    LAS unsigned char* Kt = F.lds + RING_OFF + AT_K_OFF; LAS unsigned char* Vt = F.lds + RING_OFF + AT_V_OFF; volatile LAS int* flags = (volatile LAS int*)(F.lds + RING_OFF + AT_FLAG_OFF);
    for (int u = blockIdx.x; u < AT_NU; u += F.G) {
        const bool sample = u >= AT_NUP;
        const int us = sample ? u - AT_NUP : u, head = us & 15, sb = us >> 4;
        const int nq = sample ? DECS : 256, qpos0 = sample ? PAST : 256 * sb, qrow0 = sample ? MP + DECS * sb : 256 * sb;
        const int tile_hi = (qpos0 + nq - 2) >> 6;
        f32x4 kr[4], vr[4];
        auto load_tile = [&](int tile) {
#pragma unroll
            for (int i = 0; i < 4; ++i) { const int id = tid + 512 * i, key = id >> 5, dch = id & 31, pos = 64 * tile + key;
                const float* kp; const float* vp; bool z = false;
                if (!sample) { const size_t o = (size_t)pos * D + head * HD + dch * 4; kp = pk + o; vp = pv + o; }
                else if (pos < PAST) { const size_t o = (((size_t)sb * PAST + pos) * NH + head) * HD + dch * 4; kp = ck + o; vp = cv + o; }
                else if (pos < PAST + DECS) { const size_t o = (size_t)(sb * DECS + pos - PAST) * D + head * HD + dch * 4; kp = sk + o; vp = sv + o; }
                else { z = true; kp = pk; vp = pv; }
                if (z) { kr[i] = (f32x4){0.f, 0.f, 0.f, 0.f}; vr[i] = (f32x4){0.f, 0.f, 0.f, 0.f}; } else { kr[i] = *(const f32x4*)kp; vr[i] = *(const f32x4*)vp; } }
        };
        load_tile(tile_hi);
        const bool wave_active = 32 * w < nq;
        const int rl = (32 * w + ql < nq) ? 32 * w + ql : nq - 1;
        const bool rowreal = 32 * w + ql < nq;
        bf16x8 qf[8];
#pragma unroll
        for (int ks = 0; ks < 8; ++ks) qf[ks] = wave_active ? *(const bf16x8*)(QB + (size_t)(qrow0 + rl) * D + head * HD + 16 * ks + 8 * hi) : (bf16x8){0, 0, 0, 0, 0, 0, 0, 0};
        f32x16 ot[4];
#pragma unroll
        for (int d = 0; d < 4; ++d)
#pragma unroll
            for (int r = 0; r < 16; ++r) ot[d][r] = 0.f;
        float R = rowreal ? 0.f : -1e30f;
        bool wave_done = !wave_active;
        const int tq = qpos0 + 32 * w + ql;
        for (int tile = tile_hi;; --tile) {
#pragma unroll
            for (int i = 0; i < 4; ++i) { const int id = tid + 512 * i, key = id >> 5, dch = id & 31;
                v2u a; a.x = pk2(kr[i][0], kr[i][1]); a.y = pk2(kr[i][2], kr[i][3]); *(LAS v2u*)(Kt + key * AT_STRIDE + dch * 8) = a;
                v2u b; b.x = pk2(vr[i][0], vr[i][1]); b.y = pk2(vr[i][2], vr[i][3]); *(LAS v2u*)(Vt + key * AT_STRIDE + dch * 8) = b; }
            if (tile > 0) load_tile(tile - 1);
            __syncthreads();
            const int kb = 64 * tile;
            if (!wave_done && kb < qpos0 + 32 * w + 31) {
                const bool need_mask = sample || (kb + 63 >= qpos0 + 32 * w);
                float base = R;
#pragma unroll
                for (int kbk = 1; kbk >= 0; --kbk) {
                    f32x16 p;
#pragma unroll
                    for (int r = 0; r < 16; ++r) p[r] = 0.f;
#pragma unroll
                    for (int ks = 0; ks < 8; ++ks) { const bf16x8 kf = *(const LAS bf16x8*)(Kt + (32 * kbk + ql) * AT_STRIDE + (16 * ks + 8 * hi) * 2);
                        p = __builtin_amdgcn_mfma_f32_32x32x16_bf16(kf, qf[ks], p, 0, 0, 0); }
                    float lk[16]; bool vd[16];
#pragma unroll
                    for (int r = 0; r < 16; ++r) { const float z = p[r];
                        const float sp = fmaxf(z, 0.f) + __builtin_amdgcn_logf(1.0f + __builtin_amdgcn_exp2f(-fabsf(z)));
                        vd[r] = !need_mask || (rowreal && (kb + 32 * kbk + crow16(r, hi) < tq));
                        lk[r] = vd[r] ? -sp : 0.f; p[r] = z + lk[r]; }
                    float T[4], To[4], U[4], Suf[4];
#pragma unroll
                    for (int g = 0; g < 4; ++g) { T[g] = (lk[4 * g] + lk[4 * g + 1]) + (lk[4 * g + 2] + lk[4 * g + 3]); To[g] = __shfl_xor(T[g], 32); U[g] = T[g] + To[g]; }
                    Suf[3] = 0.f; Suf[2] = U[3]; Suf[1] = U[3] + U[2]; Suf[0] = Suf[1] + U[1];
                    const float tot = Suf[0] + U[0];
                    float wg[16];
#pragma unroll
                    for (int g = 0; g < 4; ++g) { const float bg = base + Suf[g] + (hi == 0 ? To[g] : 0.f);
                        const float e2 = lk[4 * g + 3], e1 = e2 + lk[4 * g + 2], e0 = e1 + lk[4 * g + 1];
                        wg[4 * g + 3] = vd[4 * g + 3] ? __builtin_amdgcn_exp2f(p[4 * g + 3] + bg) : 0.f;
                        wg[4 * g + 2] = vd[4 * g + 2] ? __builtin_amdgcn_exp2f(p[4 * g + 2] + bg + e2) : 0.f;
                        wg[4 * g + 1] = vd[4 * g + 1] ? __builtin_amdgcn_exp2f(p[4 * g + 1] + bg + e1) : 0.f;
                        wg[4 * g + 0] = vd[4 * g + 0] ? __builtin_amdgcn_exp2f(p[4 * g + 0] + bg + e0) : 0.f; }
                    base += tot;
#pragma unroll
                    for (int s = 0; s < 2; ++s) {
                        v4u pw; pw.x = pg8::cvt_pk_bf16(wg[8 * s], wg[8 * s + 1]); pw.y = pg8::cvt_pk_bf16(wg[8 * s + 2], wg[8 * s + 3]); pw.z = pg8::cvt_pk_bf16(wg[8 * s + 4], wg[8 * s + 5]); pw.w = pg8::cvt_pk_bf16(wg[8 * s + 6], wg[8 * s + 7]);
                        const bf16x8 pf = __builtin_bit_cast(bf16x8, pw);
#pragma unroll
                        for (int d = 0; d < 4; ++d) { bf16x8 vf;
#pragma unroll
                            for (int j = 0; j < 8; ++j) vf[j] = *(const LAS short*)(Vt + (32 * kbk + crow16(8 * s + j, hi)) * AT_STRIDE + (32 * d + ql) * 2);
                            ot[d] = __builtin_amdgcn_mfma_f32_32x32x16_bf16(vf, pf, ot[d], 0, 0, 0); } }
                }
                R = base;
                wave_done = __all(R < ATT_STOP);
            }
            if (lane == 0) flags[w] = wave_done ? 1 : 0;
            __syncthreads();
            const bool alldone = __all(flags[lane & 7] != 0);
            if (alldone || tile == 0) break;
        }
        if (rowreal) { bf16* op = OB + (size_t)(qrow0 + 32 * w + ql) * D + head * HD + 4 * hi;
#pragma unroll
            for (int d = 0; d < 4; ++d)
#pragma unroll
                for (int g = 0; g < 4; ++g) { v2u o; o.x = pk2(ot[d][4 * g], ot[d][4 * g + 1]); o.y = pk2(ot[d][4 * g + 2], ot[d][4 * g + 3]); *(v2u*)(op + 32 * d + 8 * g) = o; } }
    }
}

struct Args { const float* in[26]; float* out; unsigned char* ws; int ph_lo, ph_hi; };
__global__ void __launch_bounds__(NWAVES * 64, 2) mk_fwd(Args args) {
    extern __shared__ __attribute__((aligned(16))) unsigned char lds[];
    Frame F;
    F.lds = (LAS unsigned char*)lds;
    F.MISC = (volatile LAS unsigned*)(F.lds + MISC_OFF);
    F.tid = threadIdx.x; F.lane = F.tid & 63; F.wave = __builtin_amdgcn_readfirstlane(F.tid >> 6);
    F.G = gridDim.x; { const int bx = blockIdx.x; F.vcu = (F.G % 8 == 0) ? (bx % 8) * (F.G / 8) + bx / 8 : bx; }
    F.ws = args.ws; F.out = args.out; F.in = nullptr;
    unsigned char* ws = args.ws;
    F.ctl = (gu32*)(ws + WS_CTL);
    const float* const* in = args.in;
    for (int u = F.tid; u < (LDS_BYTES - LDSCTL_OFF) / 4; u += NWAVES * 64) ((LAS unsigned*)(F.lds + LDSCTL_OFF))[u] = 0u;
    __syncthreads();
    XcdBarrier bar; bar.bar = (unsigned*)(F.ctl + CW_BAR); bar.x = 0; bar.st = nullptr;
    if (MK_N_LAUNCHES == 1) bar = xcd_barrier_post((unsigned*)(F.ctl + CW_BAR), F.MISC + 8);
    const int lo = args.ph_lo, hi = args.ph_hi;
#define IN(k) (lo <= (k) && (k) < hi)
#define SEAM(k) do { if (IN(k) && IN((k) + 1)) xcd_barrier(bar); } while (0)

    bf16* XB = (bf16*)(ws + WS_XB); float* X = args.out + O_Y;
    float* SS0 = (float*)(ws + WS_SS0); float* SS1 = (float*)(F.ctl + CW_SS1); float* SS2 = (float*)(F.ctl + CW_SS2); float* SS3 = (float*)(F.ctl + CW_SS3);
    bf16* Hb = (bf16*)(ws + WS_H);

    if (IN(0)) { p0_prologue(F, in); } SEAM(0);
    if (IN(1)) {
        pg8::Gemm g{XB, (const bf16*)(ws + WS_WIN), M, 2 * D, D}; pg8::StaticOrder S; S.init(M, 2 * D, F.G, (int)blockIdx.x);
        pg8::EpiIn E{(bf16*)(ws + WS_GATE), (bf16*)(ws + WS_REC), SS0, args.out + O_PCONV, args.out + O_SCONV};
        pg8::gemm_phase<pg8::EpiIn, pg8::StaticOrder, true, true>(F.lds + RING_OFF, g, S, E);
    } SEAM(1);
    if (IN(2)) { lru_phase<1>(F, in); } SEAM(2);
    if (IN(3)) { lru_phase<2>(F, in); } SEAM(3);
    if (IN(4)) {
        pg8::Gemm g{(const bf16*)(ws + WS_HG), (const bf16*)(ws + WS_WOUT), M, D, D}; pg8::StaticOrder S; S.init(M, D, F.G, (int)blockIdx.x);
        pg8::EpiResid<false> E{in[0], in[1], X, XB, SS1};
        pg8::gemm_phase<pg8::EpiResid<false>, pg8::StaticOrder, true, true>(F.lds + RING_OFF, g, S, E);
    } SEAM(4);
    if (IN(5)) {
        pg8::Gemm g{XB, (const bf16*)(ws + WS_WUP0), M, FF, D}; pg8::StaticOrder S; S.init(M, FF, F.G, (int)blockIdx.x);
        pg8::EpiUp E{Hb, FF, SS1};
        pg8::gemm_phase<pg8::EpiUp, pg8::StaticOrder, true, true>(F.lds + RING_OFF, g, S, E);
    } SEAM(5);
    if (IN(6)) {
        pg8::Gemm g{Hb, (const bf16*)(ws + WS_WDN0), M, D, FF}; pg8::StaticOrder S; S.init(M, D, F.G, (int)blockIdx.x);
        pg8::EpiResid<false> E{X, X + (size_t)MP * D, X, XB, SS2};
        pg8::gemm_phase<pg8::EpiResid<false>, pg8::StaticOrder, true, true>(F.lds + RING_OFF, g, S, E);
    } SEAM(6);
    if (IN(7)) {
        pg8::Gemm g{XB, (const bf16*)(ws + WS_WKVQ), M, NQKV, D}; pg8::StaticOrder S; S.init(M, NQKV, F.G, (int)blockIdx.x);
        pg8::EpiKVQ E{args.out + O_PK, args.out + O_SK, args.out + O_PV, args.out + O_SV, (bf16*)(ws + WS_QB), SS2, in[18], in[21], 0.08838834764831845f * 1.4426950408889634f, (PG8_LAS float*)(F.lds + EX_OFF)};
        pg8::gemm_phase<pg8::EpiKVQ, pg8::StaticOrder, true, true>(F.lds + RING_OFF, g, S, E);
    } SEAM(7);
    if (IN(8)) { attn_phase(F, in); } SEAM(8);
    if (IN(9)) {
        pg8::Gemm g{(const bf16*)(ws + WS_OB), (const bf16*)(ws + WS_WO), M, D, D}; pg8::StaticOrder S; S.init(M, D, F.G, (int)blockIdx.x);
        pg8::EpiResid<false> E{X, X + (size_t)MP * D, X, XB, SS3};
        pg8::gemm_phase<pg8::EpiResid<false>, pg8::StaticOrder, true, true>(F.lds + RING_OFF, g, S, E);
    } SEAM(9);
    if (IN(10)) {
        pg8::Gemm g{XB, (const bf16*)(ws + WS_WUP1), M, FF, D}; pg8::StaticOrder S; S.init(M, FF, F.G, (int)blockIdx.x);
        pg8::EpiUp E{Hb, FF, SS3};
        pg8::gemm_phase<pg8::EpiUp, pg8::StaticOrder, true, true>(F.lds + RING_OFF, g, S, E);
    } SEAM(10);
    if (IN(11)) {
        pg8::Gemm g{Hb, (const bf16*)(ws + WS_WDN1), M, D, FF}; pg8::StaticOrder S; S.init(M, D, F.G, (int)blockIdx.x);
        pg8::EpiResid<true> E{X, X + (size_t)MP * D, X, nullptr, nullptr};
        pg8::gemm_phase<pg8::EpiResid<true>, pg8::StaticOrder, true, true>(F.lds + RING_OFF, g, S, E);
    }
#undef IN
#undef SEAM
}

extern "C" void kernel_launch(void* const* d_in, const int* in_sizes, int n_in, void* d_out, int out_size, void* d_ws, size_t ws_size, hipStream_t stream) {
    static int grid = 0;
    if (grid == 0) {
        if (n_in != 26 || in_sizes[0] != MP * D || (size_t)out_size != O_END || ws_size < WS_END) { fprintf(stderr, "kernel_launch: unexpected shapes (n_in %d, in0 %d, out %d, ws %zu); nothing launched\n", n_in, n_in > 0 ? in_sizes[0] : -1, out_size, ws_size); grid = -1; return; }
        int dev = 0, cus = 0, per_cu = 0;
        if (hipGetDevice(&dev) != hipSuccess || hipDeviceGetAttribute(&cus, hipDeviceAttributeMultiprocessorCount, dev) != hipSuccess) { fprintf(stderr, "kernel_launch: hipGetDevice / hipDeviceGetAttribute failed; nothing launched\n"); grid = -1; return; }
        if (hipFuncSetAttribute((const void*)mk_fwd, hipFuncAttributeMaxDynamicSharedMemorySize, LDS_BYTES) != hipSuccess) { fprintf(stderr, "kernel_launch: hipFuncSetAttribute failed\n"); grid = -1; return; }
        if (hipOccupancyMaxActiveBlocksPerMultiprocessor(&per_cu, (const void*)mk_fwd, NWAVES * 64, LDS_BYTES) != hipSuccess || per_cu < 1)
            fprintf(stderr, "kernel_launch: note: the occupancy query reports %d workgroups per CU\n", per_cu);
        (void)hipGetLastError();
        grid = cus;
        if (grid % 16 != 0) grid -= grid % 16;
    }
    if (grid <= 0) return;
    if (hipMemsetAsync((char*)d_ws + WS_CTL, 0, CTL_ZERO_BYTES, stream) != hipSuccess) { fprintf(stderr, "kernel_launch: hipMemsetAsync of the control words failed; nothing launched\n"); return; }
    Args a{};
    for (int i = 0; i < 26; ++i) a.in[i] = (const float*)d_in[i];
    a.out = (float*)d_out; a.ws = (unsigned char*)d_ws;
    if (MK_N_LAUNCHES == 1) {
        a.ph_lo = 0; a.ph_hi = N_PHASES;
        hipLaunchKernelGGL(mk_fwd, dim3(grid), dim3(NWAVES * 64), LDS_BYTES, stream, a);
    } else {
        for (int p = 0; p < N_PHASES; ++p) { a.ph_lo = p; a.ph_hi = p + 1; hipLaunchKernelGGL(mk_fwd, dim3(grid), dim3(NWAVES * 64), LDS_BYTES, stream, a); }
    }
    const hipError_t le = hipPeekAtLastError();
    if (le != hipSuccess) fprintf(stderr, "kernel_launch: launch failed: %s (grid %d x %d threads, %d B LDS)\n", hipGetErrorName(le), grid, NWAVES * 64, LDS_BYTES);
}
```

```cpp
#include <hip/hip_runtime.h>
#include <cstdio>
#include <cstdint>
namespace pg8 {
#define PG8_LAS __attribute__((address_space(3)))
typedef unsigned short bf16_t;
typedef short bf16x8 __attribute__((ext_vector_type(8)));
typedef float f32x4 __attribute__((ext_vector_type(4)));
typedef unsigned u32x4 __attribute__((ext_vector_type(4)));
constexpr int BM = 256, BK = 64, HALF = 128, HTB = HALF * BK * 2  , STAGE_BYTES = 8 * HTB, NXCD = 8, WGM = 8;

__host__ __device__ __forceinline__ int lds_byte(int r, int c) { const int st = (r >> 4) * 2 + (c >> 5), rr = r & 15, cc = c & 31, ob = rr * 64 + cc * 2; return st * 1024 + (ob ^ (((ob >> 9) & 1) << 5)); }
__host__ __device__ __forceinline__ void stage_rc(int b, int& R, int& C) { const int st = b / 1024, sb = b % 1024, swz = sb ^ (((sb >> 9) & 1) << 5); R = (st >> 1) * 16 + swz / 64; C = (st & 1) * 32 + (swz % 64) / 2; }
__host__ __device__ __forceinline__ int perm32(int rho) { const int n = rho >> 4, i = rho & 15; return 8 * (i >> 2) + 4 * n + (i & 3); }

struct Unit { int pm, pn; };
struct Gemm { const bf16_t* A; const bf16_t* Bt; int M, N, K; };

struct StaticOrder {
    int nM, nN, nwg, G, c;
    __host__ __device__ void init(int M, int N, int G_, int c_) { nM = M / BM; nN = N / BM; nwg = nM * nN; G = G_; c = c_; }
    __host__ __device__ bool next(int i, Unit& u) const {
        const long L = (long)i * G + c; if (L >= nwg) return false;
        int wgid = (int)L; { const int q = nwg / NXCD, r = nwg % NXCD, xcd = wgid % NXCD, off = wgid / NXCD; wgid = (xcd < r ? xcd * (q + 1) : r * (q + 1) + (xcd - r) * q) + off; }
        const int nig = WGM * nN, gid = wgid / nig, fm = gid * WGM, gsz = (nM - fm) < WGM ? (nM - fm) : WGM;
        u.pm = fm + ((wgid % nig) % gsz); u.pn = (wgid % nig) / gsz; return true;
    }
    __device__ __forceinline__ void a_ready(const Unit&) const {}
    __device__ __forceinline__ void done(const Unit&) const {}
};

__device__ __forceinline__ unsigned cvt_pk_bf16(float lo, float hi) { unsigned r; asm volatile("v_cvt_pk_bf16_f32 %0, %1, %2" : "=v"(r) : "v"(lo), "v"(hi)); return r; }
__device__ __forceinline__ u32x4 pack8(const f32x4 v0, const f32x4 v1) { u32x4 w; w.x = cvt_pk_bf16(v0[0], v0[1]); w.y = cvt_pk_bf16(v0[2], v0[3]); w.z = cvt_pk_bf16(v1[0], v1[1]); w.w = cvt_pk_bf16(v1[2], v1[3]); return w; }
constexpr int MPROMPT = 16384, DM = 2048;
constexpr float RMS_EPS = 1e-6f;
__device__ __forceinline__ float rstd_of(float ss, float inv_n) { return __builtin_amdgcn_rsqf(ss * inv_n + RMS_EPS); }
__device__ __forceinline__ float gelu_tanh(float x) { const float t = x * (1.0f + 0.044715f * x * x) * (-2.302208198f); return x * __builtin_amdgcn_rcpf(1.0f + __builtin_amdgcn_exp2f(t)); }

struct EpiIn {
    static constexpr bool PERM = true, AFTER_DRAIN = false;
    bf16_t* gate; bf16_t* rec; const float* ss; float* pconv; float* sconv;
    __device__ __forceinline__ void operator()(const f32x4 (&acc)[2][2][4][2], const Unit& u, int wr, int wc, int fr, int fq) const {
        const int row0 = u.pm * BM + wr * 64 + fr; const bool is_gate = u.pn < 8; const int col0 = (u.pn & 7) * BM + wc * 32 + 8 * fq;
        bf16_t* base = is_gate ? gate : rec;
#pragma unroll
        for (int ai = 0; ai < 2; ++ai)
#pragma unroll
            for (int m = 0; m < 4; ++m) { const int row = row0 + ai * HALF + m * 16; const float rs = rstd_of(ss[row], 1.0f / 2048.0f);
                float* cdst = nullptr;
                if (!is_gate) { if (row >= MPROMPT - 3 && row < MPROMPT) cdst = pconv + (size_t)(row - (MPROMPT - 3)) * DM;
                                else if (row >= MPROMPT && ((row - MPROMPT) & 15) >= 13) cdst = sconv + ((size_t)((row - MPROMPT) >> 4) * 3 + (((row - MPROMPT) & 15) - 13)) * DM; }
#pragma unroll
                for (int bj = 0; bj < 2; ++bj) { f32x4 v0 = acc[ai][bj][m][0] * rs, v1 = acc[ai][bj][m][1] * rs;
                    if (cdst) { *(f32x4*)(cdst + col0 + bj * HALF) = v0; *(f32x4*)(cdst + col0 + bj * HALF + 4) = v1; }
                    if (is_gate) { v0 = (f32x4){gelu_tanh(v0[0]), gelu_tanh(v0[1]), gelu_tanh(v0[2]), gelu_tanh(v0[3])}; v1 = (f32x4){gelu_tanh(v1[0]), gelu_tanh(v1[1]), gelu_tanh(v1[2]), gelu_tanh(v1[3])}; }
                    *(u32x4*)(base + (size_t)row * DM + col0 + bj * HALF) = pack8(v0, v1); } }
    }
};
template <bool FINAL> struct EpiResid {
    static constexpr bool PERM = true, AFTER_DRAIN = false;
    const float* resP; const float* resS; float* X; bf16_t* XB; float* SS;
    __device__ __forceinline__ void operator()(const f32x4 (&acc)[2][2][4][2], const Unit& u, int wr, int wc, int fr, int fq) const {
        const int row0 = u.pm * BM + wr * 64 + fr, col0 = u.pn * BM + wc * 32 + 8 * fq;
        const float* rb = (u.pm < MPROMPT / BM) ? resP : resS - (size_t)MPROMPT * DM;
#pragma unroll
        for (int ai = 0; ai < 2; ++ai)
#pragma unroll
            for (int m = 0; m < 4; ++m) { const int row = row0 + ai * HALF + m * 16; const size_t off = (size_t)row * DM + col0; float q = 0.f;
#pragma unroll
                for (int bj = 0; bj < 2; ++bj) { const f32x4 r0 = *(const f32x4*)(rb + off + bj * HALF), r1 = *(const f32x4*)(rb + off + bj * HALF + 4);
                    const f32x4 x0 = r0 + acc[ai][bj][m][0], x1 = r1 + acc[ai][bj][m][1];
                    *(f32x4*)(X + off + bj * HALF) = x0; *(f32x4*)(X + off + bj * HALF + 4) = x1;
                    if (!FINAL) { *(u32x4*)(XB + off + bj * HALF) = pack8(x0, x1);
                        q += (x0[0] * x0[0] + x0[1] * x0[1]) + (x0[2] * x0[2] + x0[3] * x0[3]) + (x1[0] * x1[0] + x1[1] * x1[1]) + (x1[2] * x1[2] + x1[3] * x1[3]); } }
                if (!FINAL) { q += __shfl_xor(q, 16); q += __shfl_xor(q, 32); if (fq == 0) atomicAdd(SS + row, q); } }
    }
};
struct EpiUp {
    static constexpr bool PERM = true, AFTER_DRAIN = false;
    bf16_t* H; int ldc; const float* ss;
    __device__ __forceinline__ void operator()(const f32x4 (&acc)[2][2][4][2], const Unit& u, int wr, int wc, int fr, int fq) const {
        const int row0 = u.pm * BM + wr * 64 + fr, col0 = u.pn * BM + wc * 32 + 8 * fq;
#pragma unroll
        for (int ai = 0; ai < 2; ++ai)
#pragma unroll
            for (int m = 0; m < 4; ++m) { const int row = row0 + ai * HALF + m * 16; const float rs = rstd_of(ss[row], 1.0f / 2048.0f);
#pragma unroll
                for (int bj = 0; bj < 2; ++bj) { f32x4 v0 = acc[ai][bj][m][0] * rs, v1 = acc[ai][bj][m][1] * rs;
#pragma unroll
                    for (int e = 0; e < 4; ++e) { const float a = fmaxf(v0[e], 0.f), b = fmaxf(v1[e], 0.f); v0[e] = a * a; v1[e] = b * b; }
                    *(u32x4*)(H + (size_t)row * ldc + col0 + bj * HALF) = pack8(v0, v1); } }
    }
};
struct EpiKVQ {
    static constexpr bool PERM = true, AFTER_DRAIN = false;
    float* kP; float* kS; float* vP; float* vS; bf16_t* Q; const float* ss; const float* gk; const float* gq; float qscale; PG8_LAS float* ex;
    __device__ __forceinline__ void operator()(const f32x4 (&acc)[2][2][4][2], const Unit& u, int wr, int wc, int fr, int fq) const {
        const int row0 = u.pm * BM + wr * 64 + fr; const int kind = u.pn >> 3; const int col0 = (u.pn & 7) * BM + wc * 32 + 8 * fq;
        const bool prompt = u.pm < MPROMPT / BM;
        float rs[2][4];
#pragma unroll
        for (int ai = 0; ai < 2; ++ai)
#pragma unroll
            for (int m = 0; m < 4; ++m) rs[ai][m] = rstd_of(ss[row0 + ai * HALF + m * 16], 1.0f / 2048.0f);
        if (kind == 1) {
            float* vb = prompt ? vP : vS - (size_t)MPROMPT * DM;
#pragma unroll
            for (int ai = 0; ai < 2; ++ai)
#pragma unroll
                for (int m = 0; m < 4; ++m) { const size_t off = (size_t)(row0 + ai * HALF + m * 16) * DM + col0;
#pragma unroll
                    for (int bj = 0; bj < 2; ++bj) { *(f32x4*)(vb + off + bj * HALF) = acc[ai][bj][m][0] * rs[ai][m]; *(f32x4*)(vb + off + bj * HALF + 4) = acc[ai][bj][m][1] * rs[ai][m]; } }
            return;
        }
#pragma unroll
        for (int ai = 0; ai < 2; ++ai)
#pragma unroll
            for (int m = 0; m < 4; ++m)
#pragma unroll
                for (int bj = 0; bj < 2; ++bj) { const f32x4 v0 = acc[ai][bj][m][0] * rs[ai][m], v1 = acc[ai][bj][m][1] * rs[ai][m];
                    float q = (v0[0] * v0[0] + v0[1] * v0[1]) + (v0[2] * v0[2] + v0[3] * v0[3]) + (v1[0] * v1[0] + v1[1] * v1[1]) + (v1[2] * v1[2] + v1[3] * v1[3]);
                    q += __shfl_xor(q, 16); q += __shfl_xor(q, 32);
                    if (fq == 0) ex[((ai * HALF + wr * 64 + m * 16 + fr) * 2 + bj) * 4 + wc] = q; }
        asm volatile("s_waitcnt lgkmcnt(0)" ::: "memory"); __builtin_amdgcn_s_barrier(); asm volatile("" ::: "memory");
        const float* g = (kind == 0) ? gk : gq; const int gc0 = wc * 32 + 8 * fq;
        const f32x4 g0 = *(const f32x4*)(g + gc0), g1 = *(const f32x4*)(g + gc0 + 4);
        float* kb = prompt ? kP : kS - (size_t)MPROMPT * DM;
#pragma unroll
        for (int ai = 0; ai < 2; ++ai)
#pragma unroll
            for (int m = 0; m < 4; ++m) { const size_t off = (size_t)(row0 + ai * HALF + m * 16) * DM + col0;
#pragma unroll
                for (int bj = 0; bj < 2; ++bj) { const f32x4 e = *(const PG8_LAS f32x4*)(ex + ((ai * HALF + wr * 64 + m * 16 + fr) * 2 + bj) * 4);
                    const float hs = rstd_of((e[0] + e[1]) + (e[2] + e[3]), 1.0f / 128.0f) * rs[ai][m];
                    f32x4 v0 = acc[ai][bj][m][0] * hs * g0, v1 = acc[ai][bj][m][1] * hs * g1;
                    if (kind == 0) { *(f32x4*)(kb + off + bj * HALF) = v0; *(f32x4*)(kb + off + bj * HALF + 4) = v1; }
                    else { v0 = v0 * qscale; v1 = v1 * qscale; *(u32x4*)(Q + off + bj * HALF) = pack8(v0, v1); } } }
        asm volatile("s_waitcnt lgkmcnt(0)" ::: "memory"); __builtin_amdgcn_s_barrier(); asm volatile("" ::: "memory");
    }
};

template <class Epi, class Sched, bool ALIGN_EPI = false, bool SP2 = false>
__device__ __forceinline__ void gemm_phase(PG8_LAS unsigned char* lds, const Gemm g, const Sched& S, const Epi& E) {
    const int tid = threadIdx.x, wid = __builtin_amdgcn_readfirstlane(tid >> 6), lane = tid & 63, wr = wid >> 2, wc = wid & 3, fr = lane & 15, fq = lane >> 4;
    const int K = g.K, nt = K / BK;
    unsigned voffA[2], voffB[2];
#pragma unroll
    for (int i = 0; i < 2; ++i) { int R, C; stage_rc(tid * 16 + i * 8192, R, C); const int Rb = Epi::PERM ? ((R & ~31) + perm32(R & 31)) : R;
        voffA[i] = (unsigned)(R * K + C) * 2u; voffB[i] = (unsigned)(Rb * K + C) * 2u; }
    const size_t kstep = (size_t)(BK * 2);
    const size_t hstep = (size_t)HALF * K * 2;
    const size_t tstep = 2 * hstep;
    const unsigned ldsw = (unsigned)wid * 1024u;
    const int aoff = lds_byte(wr * 64 + fr, fq * 8), boff = lds_byte(wc * 32 + fr, fq * 8);
#define PG8_SA(b, h) (((b) * 2 + (h)) * HTB)
#define PG8_SB(b, h) ((4 + (b) * 2 + (h)) * HTB)
#define PG8_STAGE(bufoff, gbase, voff) do { _Pragma("unroll") for (int _i = 0; _i < 2; ++_i) \
        __builtin_amdgcn_global_load_lds((const unsigned*)((const char*)(gbase) + (voff)[_i]), (PG8_LAS unsigned*)(lds + (bufoff) + ldsw + _i * 8192), 16, 0, 0); } while (0)
#define PG8_LDA(dst, b, h) do { _Pragma("unroll") for (int m = 0; m < 4; ++m) _Pragma("unroll") for (int k = 0; k < 2; ++k) dst[m][k] = *(const PG8_LAS bf16x8*)(lds + PG8_SA(b, h) + aoff + m * 2048 + k * 1024); } while (0)
#define PG8_LDB(dst, b, h) do { _Pragma("unroll") for (int n = 0; n < 2; ++n) _Pragma("unroll") for (int k = 0; k < 2; ++k) dst[n][k] = *(const PG8_LAS bf16x8*)(lds + PG8_SB(b, h) + boff + n * 2048 + k * 1024); } while (0)
#define PG8_MMA(ai, bj, At, Bt) do { __builtin_amdgcn_s_setprio(1); _Pragma("unroll") for (int m = 0; m < 4; ++m) _Pragma("unroll") for (int n = 0; n < 2; ++n) _Pragma("unroll") for (int k = 0; k < 2; ++k) \
        acc[ai][bj][m][n] = __builtin_amdgcn_mfma_f32_16x16x32_bf16(Bt[n][k], At[m][k], acc[ai][bj][m][n], 0, 0, 0); __builtin_amdgcn_s_setprio(0); } while (0)
#define PG8_WAIT_V(n) asm volatile("s_waitcnt vmcnt(" #n ")" ::: "memory")
#define PG8_WAIT_L(n) asm volatile("s_waitcnt lgkmcnt(" #n ")" ::: "memory")
#define PG8_BAR __builtin_amdgcn_s_barrier()
#define PG8_SCHED __builtin_amdgcn_sched_barrier(0)
    Unit cur, nxt; int ui = 0;
    if (!S.next(0, cur)) return;
    f32x4 acc[2][2][4][2];
#pragma unroll
    for (int a = 0; a < 2; ++a)
#pragma unroll
        for (int b = 0; b < 2; ++b)
#pragma unroll
            for (int m = 0; m < 4; ++m)
#pragma unroll
                for (int n = 0; n < 2; ++n) acc[a][b][m][n] = (f32x4){0.f, 0.f, 0.f, 0.f};
    bf16x8 At[4][2], B0[2][2], B1[2][2];
    const char* cA = (const char*)g.A + (size_t)cur.pm * tstep; const char* cB = (const char*)g.Bt + (size_t)cur.pn * tstep;
    S.a_ready(cur);
    if constexpr (SP2) {
        PG8_STAGE(PG8_SB(0, 0), cB, voffB); PG8_STAGE(PG8_SB(0, 1), cB + hstep, voffB); PG8_STAGE(PG8_SA(0, 0), cA, voffA); PG8_STAGE(PG8_SA(0, 1), cA + hstep, voffA);
        if (wr == 1) PG8_BAR;
        PG8_WAIT_V(2); PG8_BAR;
        PG8_STAGE(PG8_SB(1, 0), cB + kstep, voffB); PG8_STAGE(PG8_SA(1, 0), cA + kstep, voffA); PG8_STAGE(PG8_SB(1, 1), cB + hstep + kstep, voffB);
        PG8_WAIT_V(6); PG8_BAR;
    } else {
        PG8_STAGE(PG8_SB(0, 0), cB, voffB); PG8_STAGE(PG8_SA(0, 0), cA, voffA); PG8_STAGE(PG8_SB(0, 1), cB + hstep, voffB); PG8_STAGE(PG8_SA(0, 1), cA + hstep, voffA);
        if (wr == 1) PG8_BAR;
        PG8_WAIT_V(4); PG8_BAR;
        PG8_STAGE(PG8_SB(1, 0), cB + kstep, voffB); PG8_STAGE(PG8_SA(1, 0), cA + kstep, voffA); PG8_STAGE(PG8_SB(1, 1), cB + hstep + kstep, voffB);
        PG8_WAIT_V(6); PG8_BAR;
    }
    for (;;) {
        const bool has_next = S.next(ui + 1, nxt);
        const char* nA = has_next ? (const char*)g.A + (size_t)nxt.pm * tstep : cA; const char* nB = has_next ? (const char*)g.Bt + (size_t)nxt.pn * tstep : cB;
        for (int t = 0; t < nt; t += 2) {
            const bool last = (t == nt - 2);
            const char* a1 = cA + (size_t)(t + 1) * kstep;
            const char* a2 = last ? nA : cA + (size_t)(t + 2) * kstep; const char* b2 = last ? nB : cB + (size_t)(t + 2) * kstep;
            const char* a3 = a2 + kstep; const char* b3 = b2 + kstep;
            if (last && has_next) S.a_ready(nxt);
            if constexpr (SP2) {
            PG8_LDB(B0, 0, 0); PG8_LDB(B1, 0, 1); PG8_SCHED; PG8_LDA(At, 0, 0); PG8_STAGE(PG8_SA(1, 1), a1 + hstep, voffA);
            PG8_WAIT_V(8); PG8_WAIT_L(0); PG8_BAR; PG8_MMA(0, 0, At, B0); PG8_MMA(0, 1, At, B1); PG8_BAR; PG8_SCHED;
            PG8_LDA(At, 0, 1); PG8_STAGE(PG8_SB(0, 0), b2, voffB); PG8_STAGE(PG8_SB(0, 1), b2 + hstep, voffB); PG8_STAGE(PG8_SA(0, 0), a2, voffA);
            PG8_WAIT_V(8); PG8_WAIT_L(0); PG8_BAR; PG8_MMA(1, 0, At, B0); PG8_MMA(1, 1, At, B1); PG8_BAR; PG8_SCHED;
            PG8_LDB(B0, 1, 0); PG8_LDB(B1, 1, 1); PG8_SCHED; PG8_LDA(At, 1, 0); PG8_STAGE(PG8_SA(0, 1), a2 + hstep, voffA);
            PG8_WAIT_V(8); PG8_WAIT_L(0); PG8_BAR; PG8_MMA(0, 0, At, B0); PG8_MMA(0, 1, At, B1); PG8_BAR; PG8_SCHED;
            PG8_LDA(At, 1, 1); PG8_STAGE(PG8_SB(1, 0), b3, voffB); PG8_STAGE(PG8_SB(1, 1), b3 + hstep, voffB); PG8_STAGE(PG8_SA(1, 0), a3, voffA);
            PG8_WAIT_V(8); PG8_WAIT_L(0); PG8_BAR; PG8_MMA(1, 0, At, B0); PG8_MMA(1, 1, At, B1); PG8_BAR; PG8_SCHED;
            } else {
            PG8_LDB(B0, 0, 0); PG8_SCHED; PG8_LDA(At, 0, 0); PG8_STAGE(PG8_SA(1, 1), a1 + hstep, voffA);
            PG8_WAIT_L(8); PG8_BAR; PG8_WAIT_L(0); PG8_MMA(0, 0, At, B0); PG8_BAR; PG8_SCHED;
            PG8_LDB(B1, 0, 1); PG8_STAGE(PG8_SB(0, 0), b2, voffB);
            PG8_BAR; PG8_WAIT_L(0); PG8_MMA(0, 1, At, B1); PG8_BAR;
            PG8_LDA(At, 0, 1); PG8_STAGE(PG8_SA(0, 0), a2, voffA);
            PG8_BAR; PG8_WAIT_L(0); PG8_MMA(1, 0, At, B0); PG8_BAR; PG8_SCHED;
            PG8_STAGE(PG8_SB(0, 1), b2 + hstep, voffB);
            PG8_WAIT_V(6); PG8_BAR; PG8_MMA(1, 1, At, B1); PG8_BAR;
            PG8_LDB(B0, 1, 0); PG8_SCHED; PG8_LDA(At, 1, 0); PG8_STAGE(PG8_SA(0, 1), a2 + hstep, voffA);
            PG8_WAIT_L(8); PG8_BAR; PG8_WAIT_L(0); PG8_MMA(0, 0, At, B0); PG8_BAR; PG8_SCHED;
            PG8_LDB(B1, 1, 1); PG8_STAGE(PG8_SB(1, 0), b3, voffB);
            PG8_BAR; PG8_WAIT_L(0); PG8_MMA(0, 1, At, B1); PG8_BAR;
            PG8_LDA(At, 1, 1); PG8_STAGE(PG8_SA(1, 0), a3, voffA);
            PG8_BAR; PG8_WAIT_L(0); PG8_MMA(1, 0, At, B0); PG8_BAR; PG8_SCHED;
            PG8_STAGE(PG8_SB(1, 1), b3 + hstep, voffB);
            PG8_WAIT_V(6); PG8_BAR; PG8_MMA(1, 1, At, B1); PG8_BAR;
            }
        }
        if constexpr (ALIGN_EPI) { if (wr == 0) PG8_BAR; }
        if constexpr (!Epi::AFTER_DRAIN) { E(acc, cur, wr, wc, fr, fq); S.done(cur); }
        if (!has_next) break;
#pragma unroll
        for (int a = 0; a < 2; ++a)
#pragma unroll
            for (int b = 0; b < 2; ++b)
#pragma unroll
                for (int m = 0; m < 4; ++m)
#pragma unroll
                    for (int n = 0; n < 2; ++n) acc[a][b][m][n] = (f32x4){0.f, 0.f, 0.f, 0.f};
        cur = nxt; cA = nA; cB = nB; ++ui;
        if constexpr (ALIGN_EPI) { if (wr == 1) PG8_BAR; }
    }
    PG8_WAIT_V(0);
    if constexpr (!ALIGN_EPI) { if (wr == 0) PG8_BAR; }
    PG8_BAR;
    if constexpr (Epi::AFTER_DRAIN) { E.fused(acc, cur, wr, wc, fr, fq, lds, wid, lane); S.done(cur); }
#undef PG8_SA
#undef PG8_SB
#undef PG8_STAGE
#undef PG8_LDA
#undef PG8_LDB
#undef PG8_MMA
#undef PG8_WAIT_V
#undef PG8_WAIT_L
#undef PG8_BAR
#undef PG8_SCHED
}
}

#ifndef MK_N_LAUNCHES
#define MK_N_LAUNCHES 1
#endif
constexpr int NWAVES = 8;
constexpr int N_PHASES = 12;
constexpr int D = 2048, MP = 16384, MS = 512, M = MP + MS, NH = 16, HD = 128, FF = 8192, PAST = 2048, DECB = 32, DECS = 16, NQKV = 3 * D;
constexpr int LRU_TC = 128, LRU_NCP = MP / LRU_TC  , LRU_NCS = MS / LRU_TC  ;
constexpr size_t O_Y = 0, O_PLRU = (size_t)M * D, O_PCONV = O_PLRU + D, O_PK = O_PCONV + 3 * D, O_PV = O_PK + (size_t)MP * D, O_SLRU = O_PV + (size_t)MP * D,
                 O_SCONV = O_SLRU + (size_t)DECB * D, O_SK = O_SCONV + (size_t)DECB * 3 * D, O_SV = O_SK + (size_t)MS * D, O_END = O_SV + (size_t)MS * D;
static_assert(O_END == 104079360, "d_out map");
constexpr size_t MiB = 1u << 20;
constexpr size_t WS_CTL = 0, CTL_ZERO_BYTES = 1 * MiB;
constexpr size_t WS_WIN = 2 * MiB, WS_WOUT = WS_WIN + 16 * MiB, WS_WUP0 = WS_WOUT + 8 * MiB, WS_WDN0 = WS_WUP0 + 32 * MiB, WS_WKVQ = WS_WDN0 + 32 * MiB, WS_WO = WS_WKVQ + 24 * MiB,
                 WS_WUP1 = WS_WO + 8 * MiB, WS_WDN1 = WS_WUP1 + 32 * MiB, WS_WR = WS_WDN1 + 32 * MiB, WS_WI = WS_WR + 1 * MiB, WS_AGGA = WS_WI + 1 * MiB, WS_AGGB = WS_AGGA + 1 * MiB,
                 WS_SS0 = WS_AGGB + 1 * MiB, WS_XB = WS_SS0 + 1 * MiB, WS_GATE = WS_XB + 66 * MiB, WS_REC = WS_GATE + 66 * MiB, WS_HG = WS_REC + 66 * MiB, WS_QB = WS_HG + 66 * MiB,
                 WS_OB = WS_QB + 66 * MiB, WS_H = WS_OB + 66 * MiB, WS_END = WS_H + 264 * MiB;
static_assert((size_t)M * D * 2 == 66 * MiB && (size_t)M * FF * 2 == 264 * MiB, "activation sizes");
constexpr int CW_BAR = 4096;
constexpr int CW_SS1 = 32768, CW_SS2 = CW_SS1 + 32768, CW_SS3 = CW_SS2 + 32768;
static_assert(M <= 32768 && (CW_SS3 + 32768) * 4 <= (int)CTL_ZERO_BYTES, "CTL words inside the memset region");
constexpr int RING_OFF = 0, RING_BYTES = 131072;
constexpr int EX_OFF = RING_BYTES, EX_BYTES = 8192;
constexpr int LDSCTL_OFF = EX_OFF + EX_BYTES, MISC_OFF = LDSCTL_OFF + 320;
constexpr int LDS_BYTES = 147456;
static_assert(MISC_OFF + 128 <= LDS_BYTES, "LDS map");

#define GAS __attribute__((address_space(1)))
#define LAS __attribute__((address_space(3)))
typedef unsigned short bf16;
typedef unsigned v4u __attribute__((ext_vector_type(4)));
typedef unsigned v2u __attribute__((ext_vector_type(2)));
typedef float f32x4 __attribute__((ext_vector_type(4)));
typedef float f32x16 __attribute__((ext_vector_type(16)));
typedef short bf16x8 __attribute__((ext_vector_type(8)));
typedef GAS unsigned gu32;
#define RLX_AGENT __ATOMIC_RELAXED, __HIP_MEMORY_SCOPE_AGENT
#define LDS_WAIT() asm volatile("s_waitcnt lgkmcnt(0)" ::: "memory")
#define VM_WAIT() asm volatile("s_waitcnt vmcnt(0)" ::: "memory")
__device__ __forceinline__ unsigned f2bf(float f) { unsigned u = __builtin_bit_cast(unsigned, f); return (u + 0x7fffu + ((u >> 16) & 1u)) >> 16; }
__device__ __forceinline__ unsigned pk2(float lo, float hi) { return f2bf(lo) | (f2bf(hi) << 16); }
__device__ __forceinline__ float bf2f(unsigned short b) { return __builtin_bit_cast(float, (unsigned)b << 16); }
__device__ __forceinline__ float sigmoidf_(float x) { return __builtin_amdgcn_rcpf(1.0f + __builtin_amdgcn_exp2f(-1.4426950408889634f * x)); }
#define XB_TMO      128
#define XB_XCNT(j)  (256  + 64 * (j))
#define XB_XSUB(j)  (1280 + 64 * (j))
#define XB_XGEN(j)  (2304 + 64 * (j))
#define XB_TOP      3328
#define XB_TOPGEN   3392
#define XCD_BAR_WORDS 3456
#define XB_SPIN_CAP (1u << 21)

__device__ __forceinline__ unsigned xb_ld(unsigned* p)              { return __hip_atomic_load(p, __ATOMIC_RELAXED, __HIP_MEMORY_SCOPE_AGENT); }
__device__ __forceinline__ unsigned xb_add(unsigned* p, unsigned v) { return __hip_atomic_fetch_add(p, v, __ATOMIC_RELAXED, __HIP_MEMORY_SCOPE_AGENT); }
__device__ __forceinline__ unsigned xb_xcc_id() { return (unsigned)__builtin_amdgcn_s_getreg((3 << 11) | 20) & 0xFu; }
#define XB_SPIN(cond, bar) do { unsigned _sp = 0; while (cond) { __builtin_amdgcn_s_sleep(1); \
    if ((++_sp & 255u) == 0u) { if (xb_ld(&(bar)[XB_TMO])) break; if (_sp > XB_SPIN_CAP) { atomicAdd(&(bar)[XB_TMO], 1u); break; } } } } while (0)

struct XcdBarrier {
    unsigned* bar; unsigned x;
    volatile LAS unsigned* st;
};

__device__ __forceinline__ XcdBarrier xcd_barrier_post(unsigned* bar, volatile LAS unsigned* st) {
    XcdBarrier b; b.bar = bar; b.x = xb_xcc_id(); b.st = st;
    if (threadIdx.x == 0) (void)xb_add(&bar[XB_XCNT(b.x)], 1u);
    return b;
}
__device__ __forceinline__ void xcd_barrier_complete(unsigned* bar, unsigned x, unsigned& nloc, unsigned& nx) {
    const unsigned G = gridDim.x * gridDim.y * gridDim.z;
    unsigned sum, cnt, mine, sp = 0u;
    for (;;) {
        sum = 0u; cnt = 0u; mine = 0u;
#pragma unroll
        for (unsigned j = 0; j < 16; ++j) { const unsigned c = xb_ld(&bar[XB_XCNT(j)]); sum += c; cnt += (c > 0u) ? 1u : 0u; mine = (j == x) ? c : mine; }
        if (sum == G) break;
        __builtin_amdgcn_s_sleep(1);
        if ((++sp & 255u) == 0u) { if (xb_ld(&bar[XB_TMO])) break; if (sp > XB_SPIN_CAP) { atomicAdd(&bar[XB_TMO], 1u); break; } }
    }
    nloc = mine > 0u ? mine : 1u; nx = cnt > 0u ? cnt : 1u;
}

__device__ __forceinline__ void xcd_barrier(const XcdBarrier& b) {
    asm volatile("s_waitcnt vmcnt(0)" ::: "memory");
    __syncthreads();
    if (threadIdx.x == 0) {
        unsigned* bar = b.bar;
        __builtin_amdgcn_s_waitcnt(0);
        unsigned nloc = b.st[0], nx = b.st[1];
        if (nloc == 0u) { xcd_barrier_complete(bar, b.x, nloc, nx); b.st[0] = nloc; b.st[1] = nx; }
        const unsigned old = xb_add(&bar[XB_XSUB(b.x)], 1u);
        const unsigned gen = old / nloc;
        if (old + 1u == (gen + 1u) * nloc) {
            __builtin_amdgcn_fence(__ATOMIC_RELEASE, "agent");
            asm volatile("s_waitcnt vmcnt(0)" ::: "memory");
            const unsigned og = xb_add(&bar[XB_TOP], 1u);
            const unsigned tg = og / nx;
            if (og + 1u == (tg + 1u) * nx) xb_add(&bar[XB_TOPGEN], 1u);
            else XB_SPIN(xb_ld(&bar[XB_TOPGEN]) == tg, bar);
            __builtin_amdgcn_fence(__ATOMIC_ACQUIRE, "agent");
            xb_add(&bar[XB_XGEN(b.x)], 1u);
            asm volatile("s_waitcnt vmcnt(0)" ::: "memory");
        } else {
            XB_SPIN(xb_ld(&bar[XB_XGEN(b.x)]) == gen, bar);
            __builtin_amdgcn_fence(__ATOMIC_ACQUIRE, "agent");
            asm volatile("s_waitcnt vmcnt(0)" ::: "memory");
        }
    }
    __syncthreads();
}

struct Frame {
    LAS unsigned char* lds;
    volatile LAS unsigned* MISC;
    gu32* ctl;
    int tid, lane, wave;
    int vcu, G;
    const float* const* in;
    unsigned char* ws; float* out;
};

__device__ __forceinline__ float wave_sum(float v) {
#pragma unroll
    for (int o = 1; o < 64; o <<= 1) v += __shfl_xor(v, o);
    return v;
}
__device__ __forceinline__ void p0_transpose_item(const float* W, int K, int N, bf16* WT, int row_off, const float* gain, LAS float* scr, int item, int lane) {
    const int nblk = N / 32, kb = item / nblk, nb = item % nblk, k0 = 64 * kb, n0 = 32 * nb;
#pragma unroll 8
    for (int i = 0; i < 32; ++i) { const int kk = 2 * i + (lane >> 5); const float gk = gain ? gain[k0 + kk] : 1.0f; scr[kk * 33 + (lane & 31)] = W[(size_t)(k0 + kk) * N + n0 + (lane & 31)] * gk; }
    LDS_WAIT(); asm volatile("" ::: "memory");
    const int c = lane & 7;
#pragma unroll
    for (int j = 0; j < 4; ++j) { const int n = (lane >> 3) + 8 * j; const LAS float* s = scr + (8 * c) * 33 + n;
        v4u o; o.x = pk2(s[0 * 33], s[1 * 33]); o.y = pk2(s[2 * 33], s[3 * 33]); o.z = pk2(s[4 * 33], s[5 * 33]); o.w = pk2(s[6 * 33], s[7 * 33]);
        *(GAS v4u*)(WT + (size_t)(row_off + n0 + n) * K + k0 + 8 * c) = o; }
    LDS_WAIT(); asm volatile("" ::: "memory");
}
__device__ __forceinline__ void x_row_to_bf16(const float* xrow, bf16* orow, float* ssp, int lane) {
    const GAS f32x4* xr = (const GAS f32x4*)xrow + lane;
    f32x4 v[8]; float s = 0.f;
#pragma unroll
    for (int j = 0; j < 8; ++j) { v[j] = xr[64 * j]; s += (v[j].x * v[j].x + v[j].y * v[j].y) + (v[j].z * v[j].z + v[j].w * v[j].w); }
    s = wave_sum(s);
    GAS unsigned long long* o8 = (GAS unsigned long long*)orow + lane;
#pragma unroll
    for (int j = 0; j < 8; ++j) o8[64 * j] = (unsigned long long)pk2(v[j].x, v[j].y) | ((unsigned long long)pk2(v[j].z, v[j].w) << 32);
    if (lane == 0) *ssp = s;
}
struct P0Args { const float* const* in; unsigned char* ws; };
__device__ __forceinline__ void p0_prologue(Frame& F, const float* const* in) {
    LAS float* scr = (LAS float*)(F.lds + RING_OFF + F.wave * 16384);
    const int gw = F.vcu * NWAVES + F.wave, NGW = F.G * NWAVES;
    unsigned char* ws = F.ws;
    constexpr int I_IN = (D / 64) * (2 * D / 32), I_SQ = (D / 64) * (D / 32), I_UP = (D / 64) * (FF / 32), I_DN = (FF / 64) * (D / 32), I_G = 16 * (HD / 64) * (HD / 32);
    constexpr int NITEMS = I_IN + I_SQ + I_UP + I_DN + I_IN + I_SQ + I_SQ + I_UP + I_DN + I_G + I_G;
    for (int it = gw; it < NITEMS; it += NGW) {
        int r = it;
        if (r < I_IN) { p0_transpose_item(in[7], D, 2 * D, (bf16*)(ws + WS_WIN), 0, in[6], scr, r, F.lane); continue; } r -= I_IN;
        if (r < I_SQ) { p0_transpose_item(in[15], D, D, (bf16*)(ws + WS_WOUT), 0, nullptr, scr, r, F.lane); continue; } r -= I_SQ;
        if (r < I_UP) { p0_transpose_item(in[24], D, FF, (bf16*)(ws + WS_WUP0), 0, in[23], scr, r, F.lane); continue; } r -= I_UP;
        if (r < I_DN) { p0_transpose_item(in[25], FF, D, (bf16*)(ws + WS_WDN0), 0, nullptr, scr, r, F.lane); continue; } r -= I_DN;
        if (r < I_IN) { p0_transpose_item(in[17], D, 2 * D, (bf16*)(ws + WS_WKVQ), 0, in[16], scr, r, F.lane); continue; } r -= I_IN;
        if (r < I_SQ) { p0_transpose_item(in[20], D, D, (bf16*)(ws + WS_WKVQ), 2 * D, in[19], scr, r, F.lane); continue; } r -= I_SQ;
        if (r < I_SQ) { p0_transpose_item(in[22], D, D, (bf16*)(ws + WS_WO), 0, nullptr, scr, r, F.lane); continue; } r -= I_SQ;
        if (r < I_UP) { p0_transpose_item(in[24] + (size_t)D * FF, D, FF, (bf16*)(ws + WS_WUP1), 0, in[23] + D, scr, r, F.lane); continue; } r -= I_UP;
        if (r < I_DN) { p0_transpose_item(in[25] + (size_t)D * FF, FF, D, (bf16*)(ws + WS_WDN1), 0, nullptr, scr, r, F.lane); continue; } r -= I_DN;
        if (r < I_G) { const int h = r / 8; p0_transpose_item(in[10] + (size_t)h * HD * HD, HD, HD, (bf16*)(ws + WS_WR) + (size_t)h * HD * HD, 0, nullptr, scr, r % 8, F.lane); continue; } r -= I_G;
        { const int h = r / 8; p0_transpose_item(in[12] + (size_t)h * HD * HD, HD, HD, (bf16*)(ws + WS_WI) + (size_t)h * HD * HD, 0, nullptr, scr, r % 8, F.lane); }
    }
    bf16* XB = (bf16*)(ws + WS_XB); float* SS0 = (float*)(ws + WS_SS0);
    for (int m = gw; m < M; m += NGW) x_row_to_bf16(m < MP ? in[0] + (size_t)m * D : in[1] + (size_t)(m - MP) * D, XB + (size_t)m * D, SS0 + m, F.lane);
}

constexpr int CB_STRIDE = 272;
constexpr int LRU_CB_OFF = 0, LRU_GT_OFF = 128 * CB_STRIDE;
template <int PASS> __device__ __forceinline__ void lru_phase(Frame& F, const float* const* in) {
    typedef float f32x4v __attribute__((ext_vector_type(4)));
    const int tid = F.tid, lane = F.lane, w = F.wave, fr = lane & 15, fq = lane >> 4;
    const int nslot = F.G / 16, h = blockIdx.x % 16, slot = blockIdx.x / 16;
    if (slot >= nslot) return;
    unsigned char* ws = F.ws;
    const bf16* REC = (const bf16*)(ws + WS_REC); const bf16* GATE = (const bf16*)(ws + WS_GATE); bf16* HG = (bf16*)(ws + WS_HG);
    float* AGGA = (float*)(ws + WS_AGGA); float* AGGB = (float*)(ws + WS_AGGB);
    LAS unsigned char* Cb = F.lds + RING_OFF + LRU_CB_OFF; LAS unsigned char* Gt = F.lds + RING_OFF + LRU_GT_OFF;
    const int ch = h * HD + 16 * w + fr;
    const float br = in[11][ch], bi = in[13][ch];
    float sp2;
    { const float lam = in[14][ch]; const float sp = fmaxf(-lam, 0.f) + log1pf(expf(-fabsf(lam))); sp2 = 8.0f * sp * 1.4426950408889634f; }
    bf16x8 wrf[4], wif[4];
    { const bf16* wr_t = (const bf16*)(ws + WS_WR) + ((size_t)(h * HD + 16 * w + fr) * HD + 8 * fq); const bf16* wi_t = (const bf16*)(ws + WS_WI) + ((size_t)(h * HD + 16 * w + fr) * HD + 8 * fq);
#pragma unroll
      for (int ks = 0; ks < 4; ++ks) { wrf[ks] = *(const bf16x8*)(wr_t + 32 * ks); wif[ks] = *(const bf16x8*)(wi_t + 32 * ks); } }
    const int ch4 = (tid & 31) * 4, rg = tid >> 5;
    f32x4v cw[4], cbv;
#pragma unroll
    for (int k = 0; k < 4; ++k) cw[k] = *(const f32x4v*)(in[8] + (size_t)k * D + h * HD + ch4);
    cbv = *(const f32x4v*)(in[9] + h * HD + ch4);
    const int nchunk = (PASS == 1) ? LRU_NCP : (LRU_NCP + LRU_NCS);
    for (int c = slot; c < nchunk; c += nslot) {
        const bool sample = c >= LRU_NCP;
        const int row0 = sample ? MP + (c - LRU_NCP) * LRU_TC : c * LRU_TC;
        __syncthreads();
        {
            float xr[11][4];
#pragma unroll
            for (int k = 0; k < 11; ++k) {
                const int lr = rg * 8 - 3 + k;
                bool zero = false; const float* st = nullptr;
                if (k < 3) { if (sample) { if ((rg & 1) == 0) st = in[3] + ((size_t)((row0 - MP + rg * 8) >> 4) * 3 + k) * D + h * HD + ch4; }
                             else if (c == 0 && rg == 0) zero = true; }
                if (zero) { xr[k][0] = xr[k][1] = xr[k][2] = xr[k][3] = 0.f; }
                else if (st) { const f32x4v s4 = *(const f32x4v*)st; xr[k][0] = s4[0]; xr[k][1] = s4[1]; xr[k][2] = s4[2]; xr[k][3] = s4[3]; }
                else { const v2u p = *(const v2u*)(REC + (size_t)(row0 + lr) * D + h * HD + ch4);
                       xr[k][0] = __builtin_bit_cast(float, p.x << 16); xr[k][1] = __builtin_bit_cast(float, p.x & 0xffff0000u); xr[k][2] = __builtin_bit_cast(float, p.y << 16); xr[k][3] = __builtin_bit_cast(float, p.y & 0xffff0000u); }
            }
#pragma unroll
            for (int r = 0; r < 8; ++r) { float o[4];
#pragma unroll
                for (int e = 0; e < 4; ++e) o[e] = cbv[e] + cw[0][e] * xr[r][e] + cw[1][e] * xr[r + 1][e] + cw[2][e] * xr[r + 2][e] + cw[3][e] * xr[r + 3][e];
                v2u pk; pk.x = pk2(o[0], o[1]); pk.y = pk2(o[2], o[3]);
                *(LAS v2u*)(Cb + (rg * 8 + r) * CB_STRIDE + ch4 * 2) = pk; }
            if (PASS == 2) {
#pragma unroll
                for (int i = 0; i < 4; ++i) { const int id = tid + 512 * i, rr = id >> 4, cc = id & 15;
                    *(LAS v4u*)(Gt + rr * CB_STRIDE + cc * 16) = *(const v4u*)(GATE + (size_t)(row0 + rr) * D + h * HD + cc * 8); }
            }
        }
        __syncthreads();
        float Hin = 0.f;
        if (PASS == 2 && !sample) {
            const int lo = (c * fq) >> 2, hi = (c * (fq + 1)) >> 2;
            float Ap = 1.f, Bp = 0.f;
            for (int cc = lo; cc < hi; ++cc) { const float a = AGGA[(size_t)cc * D + ch], b = AGGB[(size_t)cc * D + ch]; Bp = a * Bp + b; Ap = a * Ap; }
            { const float Aq = __shfl_up(Ap, 16), Bq = __shfl_up(Bp, 16); if (fq >= 1) { Bp = Ap * Bq + Bp; Ap = Ap * Aq; } }
            { const float Aq = __shfl_up(Ap, 32), Bq = __shfl_up(Bp, 32); if (fq >= 2) { Bp = Ap * Bq + Bp; Ap = Ap * Aq; } }
            Hin = __shfl(Bp, 48 + fr);
        }
        float Atot = 1.f, Btot = 0.f;
#pragma unroll 1
        for (int mt = 0; mt < LRU_TC / 16; ++mt) {
            const int t0 = mt * 16;
            f32x4v racc = {0.f, 0.f, 0.f, 0.f}, iacc = {0.f, 0.f, 0.f, 0.f};
#pragma unroll
            for (int ks = 0; ks < 4; ++ks) { const bf16x8 af = *(const LAS bf16x8*)(Cb + (t0 + fr) * CB_STRIDE + (32 * ks + 8 * fq) * 2);
                racc = __builtin_amdgcn_mfma_f32_16x16x32_bf16(af, wrf[ks], racc, 0, 0, 0); iacc = __builtin_amdgcn_mfma_f32_16x16x32_bf16(af, wif[ks], iacc, 0, 0, 0); }
            if (PASS == 2 && sample) Hin = in[2][(size_t)((row0 - MP + t0) >> 4) * D + ch];
            float pa[4], pb[4]; float Ar = 1.f, Br = 0.f;
#pragma unroll
            for (int r = 0; r < 4; ++r) { const int t = t0 + 4 * fq + r;
                const float cv = bf2f(*(const LAS unsigned short*)(Cb + t * CB_STRIDE + (16 * w + fr) * 2));
                const float rr = sigmoidf_(racc[r] + br), ii = sigmoidf_(iacc[r] + bi);
                const float a = __builtin_amdgcn_exp2f(-rr * sp2);
                float mult = __builtin_sqrtf(fmaxf(1.0f - a * a, 0.f));
                if (!sample && row0 + t == 0) mult = 1.0f;
                const float b = mult * ii * cv;
                Br = a * Br + b; Ar = a * Ar; pa[r] = Ar; pb[r] = Br; }
            float Ai = Ar, Bi = Br;
            { const float Aq = __shfl_up(Ai, 16), Bq = __shfl_up(Bi, 16); if (fq >= 1) { Bi = Ai * Bq + Bi; Ai = Ai * Aq; } }
            { const float Aq = __shfl_up(Ai, 32), Bq = __shfl_up(Bi, 32); if (fq >= 2) { Bi = Ai * Bq + Bi; Ai = Ai * Aq; } }
            if (PASS == 1) {
                const float At = __shfl(Ai, 48 + fr), Bt = __shfl(Bi, 48 + fr);
                Btot = At * Btot + Bt; Atot = At * Atot;
            } else {
                float Ae = __shfl_up(Ai, 16), Be = __shfl_up(Bi, 16); if (fq == 0) { Ae = 1.f; Be = 0.f; }
                const float hin = Ae * Hin + Be;
                float hv[4];
#pragma unroll
                for (int r = 0; r < 4; ++r) hv[r] = pa[r] * hin + pb[r];
#pragma unroll
                for (int r = 0; r < 4; ++r) { const int t = t0 + 4 * fq + r; LAS unsigned short* gp = (LAS unsigned short*)(Gt + t * CB_STRIDE + (16 * w + fr) * 2);
                    const float g = bf2f(*gp); *gp = (unsigned short)f2bf(hv[r] * g); }
                if (fq == 3) {
                    if (sample) F.out[O_SLRU + (size_t)((row0 - MP + t0) >> 4) * D + ch] = hv[3];
                    else if (c == LRU_NCP - 1 && mt == LRU_TC / 16 - 1) F.out[O_PLRU + ch] = hv[3];
                }
                Hin = __shfl(hv[3], 48 + fr);
            }
        }
        if (PASS == 1) { if (fq == 0) { AGGA[(size_t)c * D + ch] = Atot; AGGB[(size_t)c * D + ch] = Btot; } }
        else {
            __syncthreads();
#pragma unroll
            for (int i = 0; i < 4; ++i) { const int id = tid + 512 * i, rr = id >> 4, cc = id & 15;
                *(v4u*)(HG + (size_t)(row0 + rr) * D + h * HD + cc * 8) = *(const LAS v4u*)(Gt + rr * CB_STRIDE + cc * 16); }
        }
    }
}

constexpr int AT_STRIDE = 272, AT_K_OFF = 0, AT_V_OFF = 64 * AT_STRIDE, AT_FLAG_OFF = 2 * 64 * AT_STRIDE;
constexpr float ATT_STOP = -160.0f;
constexpr int AT_NUP = (MP / 256) * NH, AT_NUS = DECB * NH, AT_NU = AT_NUP + AT_NUS;
__device__ __forceinline__ int crow16(int r, int hi) { return (r & 3) + 8 * (r >> 2) + 4 * hi; }
__device__ __forceinline__ void attn_phase(Frame& F, const float* const* in) {
    const int tid = F.tid, lane = F.lane, w = F.wave, ql = lane & 31, hi = lane >> 5;
    unsigned char* ws = F.ws;
    const bf16* QB = (const bf16*)(ws + WS_QB); bf16* OB = (bf16*)(ws + WS_OB);
    const float* pk = F.out + O_PK; const float* pv = F.out + O_PV; const float* sk = F.out + O_SK; const float* sv = F.out + O_SV; const float* ck = in[4]; const float* cv = in[5];
    LAS unsigned char* Kt = F.lds + RING_OFF + AT_K_OFF; LAS unsigned char* Vt = F.lds + RING_OFF + AT_V_OFF; volatile LAS int* flags = (volatile LAS int*)(F.lds + RING_OFF + AT_FLAG_OFF);
    for (int u = blockIdx.x; u < AT_NU; u += F.G) {
        const bool sample = u >= AT_NUP;
        const int us = sample ? u - AT_NUP : u, head = us & 15, sb = us >> 4;
        const int nq = sample ? DECS : 256, qpos0 = sample ? PAST : 256 * sb, qrow0 = sample ? MP + DECS * sb : 256 * sb;
        const int tile_hi = (qpos0 + nq - 2) >> 6;
        f32x4 kr[4], vr[4];
        auto load_tile = [&](int tile) {
#pragma unroll
            for (int i = 0; i < 4; ++i) { const int id = tid + 512 * i, key = id >> 5, dch = id & 31, pos = 64 * tile + key;
                const float* kp; const float* vp; bool z = false;
                if (!sample) { const size_t o = (size_t)pos * D + head * HD + dch * 4; kp = pk + o; vp = pv + o; }
                else if (pos < PAST) { const size_t o = (((size_t)sb * PAST + pos) * NH + head) * HD + dch * 4; kp = ck + o; vp = cv + o; }
                else if (pos < PAST + DECS) { const size_t o = (size_t)(sb * DECS + pos - PAST) * D + head * HD + dch * 4; kp = sk + o; vp = sv + o; }
                else { z = true; kp = pk; vp = pv; }
                if (z) { kr[i] = (f32x4){0.f, 0.f, 0.f, 0.f}; vr[i] = (f32x4){0.f, 0.f, 0.f, 0.f}; } else { kr[i] = *(const f32x4*)kp; vr[i] = *(const f32x4*)vp; } }
        };
        load_tile(tile_hi);
        const bool wave_active = 32 * w < nq;
        const int rl = (32 * w + ql < nq) ? 32 * w + ql : nq - 1;
        const bool rowreal = 32 * w + ql < nq;
        bf16x8 qf[8];
#pragma unroll
        for (int ks = 0; ks < 8; ++ks) qf[ks] = wave_active ? *(const bf16x8*)(QB + (size_t)(qrow0 + rl) * D + head * HD + 16 * ks + 8 * hi) : (bf16x8){0, 0, 0, 0, 0, 0, 0, 0};
        f32x16 ot[4];
#pragma unroll
        for (int d = 0; d < 4; ++d)
#pragma unroll
            for (int r = 0; r < 16; ++r) ot[d][r] = 0.f;
        float R = rowreal ? 0.f : -1e30f;
        bool wave_done = !wave_active;
        const int tq = qpos0 + 32 * w + ql;
        for (int tile = tile_hi;; --tile) {
#pragma unroll
            for (int i = 0; i < 4; ++i) { const int id = tid + 512 * i, key = id >> 5, dch = id & 31;
                v2u a; a.x = pk2(kr[i][0], kr[i][1]); a.y = pk2(kr[i][2], kr[i][3]); *(LAS v2u*)(Kt + key * AT_STRIDE + dch * 8) = a;
                v2u b; b.x = pk2(vr[i][0], vr[i][1]); b.y = pk2(vr[i][2], vr[i][3]); *(LAS v2u*)(Vt + key * AT_STRIDE + dch * 8) = b; }
            if (tile > 0) load_tile(tile - 1);
            __syncthreads();
            const int kb = 64 * tile;
            if (!wave_done && kb < qpos0 + 32 * w + 31) {
                const bool need_mask = sample || (kb + 63 >= qpos0 + 32 * w);
                float base = R;
#pragma unroll
                for (int kbk = 1; kbk >= 0; --kbk) {
                    f32x16 p;
#pragma unroll
                    for (int r = 0; r < 16; ++r) p[r] = 0.f;
#pragma unroll
                    for (int ks = 0; ks < 8; ++ks) { const bf16x8 kf = *(const LAS bf16x8*)(Kt + (32 * kbk + ql) * AT_STRIDE + (16 * ks + 8 * hi) * 2);
                        p = __builtin_amdgcn_mfma_f32_32x32x16_bf16(kf, qf[ks], p, 0, 0, 0); }
                    float lk[16]; bool vd[16];
#pragma unroll
                    for (int r = 0; r < 16; ++r) { const float z = p[r];
                        const float sp = fmaxf(z, 0.f) + __builtin_amdgcn_logf(1.0f + __builtin_amdgcn_exp2f(-fabsf(z)));
                        vd[r] = !need_mask || (rowreal && (kb + 32 * kbk + crow16(r, hi) < tq));
                        lk[r] = vd[r] ? -sp : 0.f; p[r] = z + lk[r]; }
                    float T[4], To[4], U[4], Suf[4];
#pragma unroll
                    for (int g = 0; g < 4; ++g) { T[g] = (lk[4 * g] + lk[4 * g + 1]) + (lk[4 * g + 2] + lk[4 * g + 3]); To[g] = __shfl_xor(T[g], 32); U[g] = T[g] + To[g]; }
                    Suf[3] = 0.f; Suf[2] = U[3]; Suf[1] = U[3] + U[2]; Suf[0] = Suf[1] + U[1];
                    const float tot = Suf[0] + U[0];
                    float wg[16];
#pragma unroll
                    for (int g = 0; g < 4; ++g) { const float bg = base + Suf[g] + (hi == 0 ? To[g] : 0.f);
                        const float e2 = lk[4 * g + 3], e1 = e2 + lk[4 * g + 2], e0 = e1 + lk[4 * g + 1];
                        wg[4 * g + 3] = vd[4 * g + 3] ? __builtin_amdgcn_exp2f(p[4 * g + 3] + bg) : 0.f;
                        wg[4 * g + 2] = vd[4 * g + 2] ? __builtin_amdgcn_exp2f(p[4 * g + 2] + bg + e2) : 0.f;
                        wg[4 * g + 1] = vd[4 * g + 1] ? __builtin_amdgcn_exp2f(p[4 * g + 1] + bg + e1) : 0.f;
                        wg[4 * g + 0] = vd[4 * g + 0] ? __builtin_amdgcn_exp2f(p[4 * g + 0] + bg + e0) : 0.f; }
                    base += tot;
#pragma unroll
                    for (int s = 0; s < 2; ++s) {
                        v4u pw; pw.x = pg8::cvt_pk_bf16(wg[8 * s], wg[8 * s + 1]); pw.y = pg8::cvt_pk_bf16(wg[8 * s + 2], wg[8 * s + 3]); pw.z = pg8::cvt_pk_bf16(wg[8 * s + 4], wg[8 * s + 5]); pw.w = pg8::cvt_pk_bf16(wg[8 * s + 6], wg[8 * s + 7]);
                        const bf16x8 pf = __builtin_bit_cast(bf16x8, pw);
#pragma unroll
                        for (int d = 0; d < 4; ++d) { bf16x8 vf;
#pragma unroll
                            for (int j = 0; j < 8; ++j) vf[j] = *(const LAS short*)(Vt + (32 * kbk + crow16(8 * s + j, hi)) * AT_STRIDE + (32 * d + ql) * 2);
                            ot[d] = __builtin_amdgcn_mfma_f32_32x32x16_bf16(vf, pf, ot[d], 0, 0, 0); } }
                }
                R = base;
                wave_done = __all(R < ATT_STOP);
            }
            if (lane == 0) flags[w] = wave_done ? 1 : 0;
            __syncthreads();
            const bool alldone = __all(flags[lane & 7] != 0);
            if (alldone || tile == 0) break;
        }
        if (rowreal) { bf16* op = OB + (size_t)(qrow0 + 32 * w + ql) * D + head * HD + 4 * hi;
#pragma unroll
            for (int d = 0; d < 4; ++d)
#pragma unroll
                for (int g = 0; g < 4; ++g) { v2u o; o.x = pk2(ot[d][4 * g], ot[d][4 * g + 1]); o.y = pk2(ot[d][4 * g + 2], ot[d][4 * g + 3]); *(v2u*)(op + 32 * d + 8 * g) = o; } }
    }
}

struct Args { const float* in[26]; float* out; unsigned char* ws; int ph_lo, ph_hi; };
__global__ void __launch_bounds__(NWAVES * 64, 2) mk_fwd(Args args) {
    extern __shared__ __attribute__((aligned(16))) unsigned char lds[];
    Frame F;
    F.lds = (LAS unsigned char*)lds;
    F.MISC = (volatile LAS unsigned*)(F.lds + MISC_OFF);
    F.tid = threadIdx.x; F.lane = F.tid & 63; F.wave = __builtin_amdgcn_readfirstlane(F.tid >> 6);
    F.G = gridDim.x; { const int bx = blockIdx.x; F.vcu = (F.G % 8 == 0) ? (bx % 8) * (F.G / 8) + bx / 8 : bx; }
    F.ws = args.ws; F.out = args.out; F.in = nullptr;
    unsigned char* ws = args.ws;
    F.ctl = (gu32*)(ws + WS_CTL);
    const float* const* in = args.in;
    for (int u = F.tid; u < (LDS_BYTES - LDSCTL_OFF) / 4; u += NWAVES * 64) ((LAS unsigned*)(F.lds + LDSCTL_OFF))[u] = 0u;
    __syncthreads();
    XcdBarrier bar; bar.bar = (unsigned*)(F.ctl + CW_BAR); bar.x = 0; bar.st = nullptr;
    if (MK_N_LAUNCHES == 1) bar = xcd_barrier_post((unsigned*)(F.ctl + CW_BAR), F.MISC + 8);
    const int lo = args.ph_lo, hi = args.ph_hi;
#define IN(k) (lo <= (k) && (k) < hi)
#define SEAM(k) do { if (IN(k) && IN((k) + 1)) xcd_barrier(bar); } while (0)

    bf16* XB = (bf16*)(ws + WS_XB); float* X = args.out + O_Y;
    float* SS0 = (float*)(ws + WS_SS0); float* SS1 = (float*)(F.ctl + CW_SS1); float* SS2 = (float*)(F.ctl + CW_SS2); float* SS3 = (float*)(F.ctl + CW_SS3);
    bf16* Hb = (bf16*)(ws + WS_H);

    if (IN(0)) { p0_prologue(F, in); } SEAM(0);
    if (IN(1)) {
        pg8::Gemm g{XB, (const bf16*)(ws + WS_WIN), M, 2 * D, D}; pg8::StaticOrder S; S.init(M, 2 * D, F.G, (int)blockIdx.x);
        pg8::EpiIn E{(bf16*)(ws + WS_GATE), (bf16*)(ws + WS_REC), SS0, args.out + O_PCONV, args.out + O_SCONV};
        pg8::gemm_phase<pg8::EpiIn, pg8::StaticOrder, true, true>(F.lds + RING_OFF, g, S, E);
    } SEAM(1);
    if (IN(2)) { lru_phase<1>(F, in); } SEAM(2);
    if (IN(3)) { lru_phase<2>(F, in); } SEAM(3);
    if (IN(4)) {
        pg8::Gemm g{(const bf16*)(ws + WS_HG), (const bf16*)(ws + WS_WOUT), M, D, D}; pg8::StaticOrder S; S.init(M, D, F.G, (int)blockIdx.x);
        pg8::EpiResid<false> E{in[0], in[1], X, XB, SS1};
        pg8::gemm_phase<pg8::EpiResid<false>, pg8::StaticOrder, true, true>(F.lds + RING_OFF, g, S, E);
    } SEAM(4);
    if (IN(5)) {
        pg8::Gemm g{XB, (const bf16*)(ws + WS_WUP0), M, FF, D}; pg8::StaticOrder S; S.init(M, FF, F.G, (int)blockIdx.x);
        pg8::EpiUp E{Hb, FF, SS1};
        pg8::gemm_phase<pg8::EpiUp, pg8::StaticOrder, true, true>(F.lds + RING_OFF, g, S, E);
    } SEAM(5);
    if (IN(6)) {
        pg8::Gemm g{Hb, (const bf16*)(ws + WS_WDN0), M, D, FF}; pg8::StaticOrder S; S.init(M, D, F.G, (int)blockIdx.x);
        pg8::EpiResid<false> E{X, X + (size_t)MP * D, X, XB, SS2};
        pg8::gemm_phase<pg8::EpiResid<false>, pg8::StaticOrder, true, true>(F.lds + RING_OFF, g, S, E);
    } SEAM(6);
    if (IN(7)) {
        pg8::Gemm g{XB, (const bf16*)(ws + WS_WKVQ), M, NQKV, D}; pg8::StaticOrder S; S.init(M, NQKV, F.G, (int)blockIdx.x);
        pg8::EpiKVQ E{args.out + O_PK, args.out + O_SK, args.out + O_PV, args.out + O_SV, (bf16*)(ws + WS_QB), SS2, in[18], in[21], 0.08838834764831845f * 1.4426950408889634f, (PG8_LAS float*)(F.lds + EX_OFF)};
        pg8::gemm_phase<pg8::EpiKVQ, pg8::StaticOrder, true, true>(F.lds + RING_OFF, g, S, E);
    } SEAM(7);
    if (IN(8)) { attn_phase(F, in); } SEAM(8);
    if (IN(9)) {
        pg8::Gemm g{(const bf16*)(ws + WS_OB), (const bf16*)(ws + WS_WO), M, D, D}; pg8::StaticOrder S; S.init(M, D, F.G, (int)blockIdx.x);
        pg8::EpiResid<false> E{X, X + (size_t)MP * D, X, XB, SS3};
        pg8::gemm_phase<pg8::EpiResid<false>, pg8::StaticOrder, true, true>(F.lds + RING_OFF, g, S, E);
    } SEAM(9);
    if (IN(10)) {
        pg8::Gemm g{XB, (const bf16*)(ws + WS_WUP1), M, FF, D}; pg8::StaticOrder S; S.init(M, FF, F.G, (int)blockIdx.x);
        pg8::EpiUp E{Hb, FF, SS3};
        pg8::gemm_phase<pg8::EpiUp, pg8::StaticOrder, true, true>(F.lds + RING_OFF, g, S, E);
    } SEAM(10);
    if (IN(11)) {
        pg8::Gemm g{Hb, (const bf16*)(ws + WS_WDN1), M, D, FF}; pg8::StaticOrder S; S.init(M, D, F.G, (int)blockIdx.x);
        pg8::EpiResid<true> E{X, X + (size_t)MP * D, X, nullptr, nullptr};
        pg8::gemm_phase<pg8::EpiResid<true>, pg8::StaticOrder, true, true>(F.lds + RING_OFF, g, S, E);
    }
#undef IN
#undef SEAM
}

extern "C" void kernel_launch(void* const* d_in, const int* in_sizes, int n_in, void* d_out, int out_size, void* d_ws, size_t ws_size, hipStream_t stream) {
    static int grid = 0;
    if (grid == 0) {
        if (n_in != 26 || in_sizes[0] != MP * D || (size_t)out_size != O_END || ws_size < WS_END) { fprintf(stderr, "kernel_launch: unexpected shapes (n_in %d, in0 %d, out %d, ws %zu); nothing launched\n", n_in, n_in > 0 ? in_sizes[0] : -1, out_size, ws_size); grid = -1; return; }
        int dev = 0, cus = 0, per_cu = 0;
        if (hipGetDevice(&dev) != hipSuccess || hipDeviceGetAttribute(&cus, hipDeviceAttributeMultiprocessorCount, dev) != hipSuccess) { fprintf(stderr, "kernel_launch: hipGetDevice / hipDeviceGetAttribute failed; nothing launched\n"); grid = -1; return; }
        if (hipFuncSetAttribute((const void*)mk_fwd, hipFuncAttributeMaxDynamicSharedMemorySize, LDS_BYTES) != hipSuccess) { fprintf(stderr, "kernel_launch: hipFuncSetAttribute failed\n"); grid = -1; return; }
        if (hipOccupancyMaxActiveBlocksPerMultiprocessor(&per_cu, (const void*)mk_fwd, NWAVES * 64, LDS_BYTES) != hipSuccess || per_cu < 1)
            fprintf(stderr, "kernel_launch: note: the occupancy query reports %d workgroups per CU\n", per_cu);
        (void)hipGetLastError();
        grid = cus;
        if (grid % 16 != 0) grid -= grid % 16;
    }
    if (grid <= 0) return;
    if (hipMemsetAsync((char*)d_ws + WS_CTL, 0, CTL_ZERO_BYTES, stream) != hipSuccess) { fprintf(stderr, "kernel_launch: hipMemsetAsync of the control words failed; nothing launched\n"); return; }
    Args a{};
    for (int i = 0; i < 26; ++i) a.in[i] = (const float*)d_in[i];
    a.out = (float*)d_out; a.ws = (unsigned char*)d_ws;
    if (MK_N_LAUNCHES == 1) {
        a.ph_lo = 0; a.ph_hi = N_PHASES;
        hipLaunchKernelGGL(mk_fwd, dim3(grid), dim3(NWAVES * 64), LDS_BYTES, stream, a);
    } else {
        for (int p = 0; p < N_PHASES; ++p) { a.ph_lo = p; a.ph_hi = p + 1; hipLaunchKernelGGL(mk_fwd, dim3(grid), dim3(NWAVES * 64), LDS_BYTES, stream, a); }
    }
    const hipError_t le = hipPeekAtLastError();
    if (le != hipSuccess) fprintf(stderr, "kernel_launch: launch failed: %s (grid %d x %d threads, %d B LDS)\n", hipGetErrorName(le), grid, NWAVES * 64, LDS_BYTES);
}
```
